# Optimizing an MI355X kernel written in HIP

```python
import math, functools
import jax, jax.numpy as jnp
from jax import lax
import numpy as np

D_MODEL = 2048
BATCH = 2
SEQ = 4096
DEPTH = 1
DEC_BATCH = 8
DEC_SEQ = 4
PAST_LEN = 16384
PAGE_SIZE = 128

MIX_W = D_MODEL
ATT_W = MIX_W // 2
SSM_W = MIX_W - ATT_W
V_HEAD = 128
N_HEADS = ATT_W // V_HEAD
QK_DIM = V_HEAD // 2
SSM_GROUP = 16
N_SSM_GROUPS = SSM_W // SSM_GROUP
SSM_STATE = 64
D_IN = 3 * ATT_W + SSM_W
D_FF = ((8 * D_MODEL // 3 + 127) // 128) * 128
CONV_W = 3
PLE_DIM = 256
N_BUCKETS = 32
MAX_DISTANCE = 128
Q_BLOCK = 128
NORM_EPS = 1e-6
SUBLN_EPS = 1e-5

kernel_name = "hymba_diffattn_s5_convffn_step"


def rmsnorm(x, g, eps=NORM_EPS):
    xf = x.astype(jnp.float32)
    r = xf * lax.rsqrt(jnp.mean(xf * xf, axis=-1, keepdims=True) + eps)
    return (r * g.astype(jnp.float32)).astype(x.dtype)


def t5_bucket(dist):
    max_exact = N_BUCKETS // 2
    n = jnp.maximum(dist, 0)
    nf = jnp.maximum(n, 1).astype(jnp.float32)
    large = max_exact + (jnp.log(nf / max_exact) / math.log(MAX_DISTANCE / max_exact)
                         * (N_BUCKETS - max_exact)).astype(jnp.int32)
    large = jnp.minimum(large, N_BUCKETS - 1)
    return jnp.where(n < max_exact, n, large)


def rel_bias(table, qpos, kpos):
    b = table[t5_bucket(qpos[:, None] - kpos[None, :])]
    return jnp.transpose(b, (2, 0, 1)).astype(jnp.float32)


def diff_weights(s, lam):
    p = jax.nn.softmax(s, axis=-1)
    return p[:, :, 0] - lam * p[:, :, 1]


def prompt_diff_attention(q, k, v, lam, table):
    B, T = q.shape[0], q.shape[1]
    scale = QK_DIM ** -0.5
    kpos = jnp.arange(T)

    def one_block(qb):
        start = qb * Q_BLOCK
        q_blk = lax.dynamic_slice_in_dim(q, start, Q_BLOCK, axis=1)
        qpos = start + jnp.arange(Q_BLOCK)
        s = jnp.einsum('bqhjd,bkhjd->bhjqk', q_blk, k).astype(jnp.float32) * scale
        s = s + rel_bias(table, qpos, kpos)[None, :, None]
        s = jnp.where(kpos[None, :] <= qpos[:, None], s, -jnp.inf)
        w = diff_weights(s, lam)
        return jnp.einsum('bhqk,bkhe->bqhe', w.astype(v.dtype), v)

    out = lax.map(one_block, jnp.arange(T // Q_BLOCK))
    return jnp.moveaxis(out, 0, 1).reshape(B, T, N_HEADS, V_HEAD)


def sample_diff_attention(q, k, v, lam, table, k_pool, v_pool, page_table):
    DB, S = q.shape[0], q.shape[1]
    scale = QK_DIM ** -0.5
    k_past = k_pool[page_table].reshape(DB, -1, N_HEADS, 2, QK_DIM)
    v_past = v_pool[page_table].reshape(DB, -1, N_HEADS, V_HEAD)
    P = k_past.shape[1]
    qpos = P + jnp.arange(S)
    s_past = jnp.einsum('bqhjd,bkhjd->bhjqk', q, k_past).astype(jnp.float32) * scale
    s_past = s_past + rel_bias(table, qpos, jnp.arange(P))[None, :, None]
    s_new = jnp.einsum('bqhjd,bkhjd->bhjqk', q, k).astype(jnp.float32) * scale
    s_new = s_new + rel_bias(table, qpos, qpos)[None, :, None]
    s_new = jnp.where(qpos[None, :] <= qpos[:, None], s_new, -jnp.inf)
    w = diff_weights(jnp.concatenate([s_past, s_new], axis=-1), lam).astype(v.dtype)
    return (jnp.einsum('bhqk,bkhe->bqhe', w[..., :P], v_past)
            + jnp.einsum('bhqk,bkhe->bqhe', w[..., P:], v))


def complex_affine_combine(e1, e2):
    a1r, a1i, b1r, b1i = e1
    a2r, a2i, b2r, b2i = e2
    return (a2r * a1r - a2i * a1i,
            a2r * a1i + a2i * a1r,
            a2r * b1r - a2i * b1i + b2r,
            a2r * b1i + a2i * b1r + b2i)


def s5_scan(u, h0_re, h0_im, a_re, a_im, b_re, b_im, c_re, c_im, d, log_dt):
    f32 = jnp.float32
    u = u.astype(f32)
    a_re, a_im = a_re.astype(f32), a_im.astype(f32)
    b_re, b_im = b_re.astype(f32), b_im.astype(f32)
    dt = jnp.exp(log_dt.astype(f32))[:, None]
    decay = jnp.exp(a_re * dt)
    ab_re = decay * jnp.cos(a_im * dt)
    ab_im = decay * jnp.sin(a_im * dt)
    den = a_re * a_re + a_im * a_im
    num_re = ab_re - 1.0
    coef_re = (num_re * a_re + ab_im * a_im) / den
    coef_im = (ab_im * a_re - num_re * a_im) / den
    bb_re = coef_re[..., None] * b_re - coef_im[..., None] * b_im
    bb_im = coef_re[..., None] * b_im + coef_im[..., None] * b_re
    bu_re = jnp.einsum('btgc,gnc->btgn', u, bb_re)
    bu_im = jnp.einsum('btgc,gnc->btgn', u, bb_im)
    shape = bu_re.shape
    elems = (jnp.broadcast_to(ab_re, shape), jnp.broadcast_to(ab_im, shape), bu_re, bu_im)
    acc_re, acc_im, hc_re, hc_im = lax.associative_scan(complex_affine_combine, elems, axis=1)
    h0r = h0_re.astype(f32)[:, None]
    h0i = h0_im.astype(f32)[:, None]
    h_re = hc_re + acc_re * h0r - acc_im * h0i
    h_im = hc_im + acc_re * h0i + acc_im * h0r
    y = (jnp.einsum('btgn,gcn->btgc', h_re, c_re.astype(f32))
         - jnp.einsum('btgn,gcn->btgc', h_im, c_im.astype(f32))
         + d.astype(f32) * u)
    return y, h_re[:, -1], h_im[:, -1]


def conv_ffn(x, prev, w_up, conv_w, conv_b, w_down):
    T = x.shape[1]
    up = x @ w_up
    gate, val = up[..., :D_FF], up[..., D_FF:]
    buf = jnp.concatenate([prev.astype(gate.dtype), gate], axis=1)
    conv = conv_b + sum(conv_w[j] * buf[:, j:j + T] for j in range(CONV_W))
    h = jax.nn.silu(conv) * val
    return h @ w_down, buf[:, buf.shape[1] - (CONV_W - 1):]


def decoder_layer(h, pe, lp, layer_idx, attend, h0_re, h0_im, conv_prev):
    B, T, _ = h.shape
    u = rmsnorm(h, lp['norm_mix_g'])
    z = u @ lp['w_in']
    q = z[..., :ATT_W].reshape(B, T, N_HEADS, 2, QK_DIM)
    k = z[..., ATT_W:2 * ATT_W].reshape(B, T, N_HEADS, 2, QK_DIM)
    v = z[..., 2 * ATT_W:3 * ATT_W].reshape(B, T, N_HEADS, V_HEAD)
    us = z[..., 3 * ATT_W:].reshape(B, T, N_SSM_GROUPS, SSM_GROUP)
    f32 = jnp.float32
    lam_init = 0.8 - 0.6 * math.exp(-0.3 * layer_idx)
    lam = (jnp.exp(jnp.sum(lp['lambda_q1'].astype(f32) * lp['lambda_k1'].astype(f32)))
           - jnp.exp(jnp.sum(lp['lambda_q2'].astype(f32) * lp['lambda_k2'].astype(f32))) + lam_init)
    o_att = attend(q, k, v, lam)
    o_att = rmsnorm(o_att, lp['attn_subln_g'], SUBLN_EPS) * (1.0 - lam_init)
    y, hr, hi = s5_scan(us, h0_re, h0_im, lp['ssm_a_re'], lp['ssm_a_im'], lp['ssm_b_re'], lp['ssm_b_im'],
                        lp['ssm_c_re'], lp['ssm_c_im'], lp['ssm_d'], lp['ssm_log_dt'])
    g = jax.nn.gelu(y)
    g = g * jax.nn.sigmoid(jnp.einsum('btgc,gce->btge', g, lp['ssm_glu_w'].astype(f32))
                           + lp['ssm_glu_b'].astype(f32))
    o_ssm = rmsnorm(g.reshape(B, T, SSM_W).astype(h.dtype), lp['ssm_out_g'])
    o = jnp.concatenate([o_att.reshape(B, T, ATT_W), o_ssm], axis=-1)
    h = h + o @ lp['w_out']
    f, conv_new = conv_ffn(rmsnorm(h, lp['norm_ffn_g']), conv_prev, lp['ffn_w_up'],
                           lp['ffn_conv_w'], lp['ffn_conv_b'], lp['ffn_w_down'])
    h = h + f
    gate = jax.nn.sigmoid(rmsnorm(h, lp['norm_ple_g']) @ lp['ple_w_gate'])
    h = h + gate * (pe @ lp['ple_w_proj'])
    return h, k, v, hr, hi, conv_new


def setup_inputs(seed: int = 0) -> dict:
    key = jax.random.key(seed)
    keys = iter(jax.random.split(key, 64))

    def nrm(shape, scale):
        return scale * jax.random.normal(next(keys), shape, jnp.float32)

    def gain(shape):
        return 1.0 + nrm(shape, 0.01)

    n_pages = PAST_LEN // PAGE_SIZE
    n_used = DEC_BATCH * n_pages
    n_pool = n_used + max(1, n_used // 4)
    G, N, GC = N_SSM_GROUPS, SSM_STATE, SSM_GROUP
    perm = jax.random.permutation(next(keys), n_pool)
    page_table = perm[:n_used].reshape(DEC_BATCH, n_pages).astype(jnp.int32)
    a_im = (jnp.pi * jnp.broadcast_to(jnp.arange(N, dtype=jnp.float32), (DEPTH, G, N))
            + nrm((DEPTH, G, N), 0.01))
    log_dt = jax.random.uniform(next(keys), (DEPTH, G), jnp.float32, math.log(1e-3), math.log(1e-1))
    return {
        'x_prompt': nrm((BATCH, SEQ, D_MODEL), 1.0),
        'x_sample': nrm((DEC_BATCH, DEC_SEQ, D_MODEL), 1.0),
        'cache_k': nrm((DEPTH, n_pool, PAGE_SIZE, N_HEADS, 2, QK_DIM), 1.0),
        'cache_v': nrm((DEPTH, n_pool, PAGE_SIZE, N_HEADS, V_HEAD), 1.0),
        'state_ssm_re': nrm((DEPTH, DEC_BATCH, G, N), 0.1),
        'state_ssm_im': nrm((DEPTH, DEC_BATCH, G, N), 0.1),
        'state_conv': nrm((DEPTH, DEC_BATCH, CONV_W - 1, D_FF), 1.0),
        'page_table': page_table,
        'p_prompt': nrm((DEPTH, BATCH, SEQ, PLE_DIM), 1.0),
        'p_sample': nrm((DEPTH, DEC_BATCH, DEC_SEQ, PLE_DIM), 1.0),
        'rel_bias': nrm((N_BUCKETS, N_HEADS), 0.5),
        'norm_mix_g': gain((DEPTH, D_MODEL)),
        'w_in': nrm((DEPTH, D_MODEL, D_IN), D_MODEL ** -0.5),
        'lambda_q1': nrm((DEPTH, QK_DIM), 0.1),
        'lambda_k1': nrm((DEPTH, QK_DIM), 0.1),
        'lambda_q2': nrm((DEPTH, QK_DIM), 0.1),
        'lambda_k2': nrm((DEPTH, QK_DIM), 0.1),
        'attn_subln_g': gain((DEPTH, N_HEADS, V_HEAD)),
        'ssm_a_re': -0.5 + nrm((DEPTH, G, N), 0.01),
        'ssm_a_im': a_im,
        'ssm_b_re': nrm((DEPTH, G, N, GC), (2 * GC) ** -0.5),
        'ssm_b_im': nrm((DEPTH, G, N, GC), (2 * GC) ** -0.5),
        'ssm_c_re': nrm((DEPTH, G, GC, N), N ** -0.5),
        'ssm_c_im': nrm((DEPTH, G, GC, N), N ** -0.5),
        'ssm_d': nrm((DEPTH, G, GC), 1.0),
        'ssm_log_dt': log_dt,
        'ssm_glu_w': nrm((DEPTH, G, GC, GC), GC ** -0.5),
        'ssm_glu_b': nrm((DEPTH, G, GC), 0.01),
        'ssm_out_g': gain((DEPTH, SSM_W)),
        'w_out': nrm((DEPTH, MIX_W, D_MODEL), MIX_W ** -0.5),
        'norm_ffn_g': gain((DEPTH, D_MODEL)),
        'ffn_w_up': nrm((DEPTH, D_MODEL, 2 * D_FF), D_MODEL ** -0.5),
        'ffn_conv_w': nrm((DEPTH, CONV_W, D_FF), CONV_W ** -0.5),
        'ffn_conv_b': nrm((DEPTH, D_FF), 0.01),
        'ffn_w_down': nrm((DEPTH, D_FF, D_MODEL), D_FF ** -0.5),
        'norm_ple_g': gain((DEPTH, D_MODEL)),
        'ple_w_gate': nrm((DEPTH, D_MODEL, D_MODEL), D_MODEL ** -0.5),
        'ple_w_proj': nrm((DEPTH, PLE_DIM, D_MODEL), PLE_DIM ** -0.5),
        'norm_final_g': gain((D_MODEL,)),
    }


def reference(x_prompt, x_sample, cache_k, cache_v, state_ssm_re, state_ssm_im, state_conv, page_table,
              p_prompt, p_sample, rel_bias, norm_mix_g, w_in, lambda_q1, lambda_k1, lambda_q2, lambda_k2,
              attn_subln_g, ssm_a_re, ssm_a_im, ssm_b_re, ssm_b_im, ssm_c_re, ssm_c_im, ssm_d, ssm_log_dt,
              ssm_glu_w, ssm_glu_b, ssm_out_g, w_out, norm_ffn_g, ffn_w_up, ffn_conv_w, ffn_conv_b,
              ffn_w_down, norm_ple_g, ple_w_gate, ple_w_proj, norm_final_g):
    hp, hs = x_prompt, x_sample
    kp, vp, srp, sip, cp = [], [], [], [], []
    ks, vs, srs, sis, cs = [], [], [], [], []
    for i in range(DEPTH):
        lp = {
            'norm_mix_g': norm_mix_g[i], 'w_in': w_in[i],
            'lambda_q1': lambda_q1[i], 'lambda_k1': lambda_k1[i],
            'lambda_q2': lambda_q2[i], 'lambda_k2': lambda_k2[i],
            'attn_subln_g': attn_subln_g[i],
            'ssm_a_re': ssm_a_re[i], 'ssm_a_im': ssm_a_im[i],
            'ssm_b_re': ssm_b_re[i], 'ssm_b_im': ssm_b_im[i],
            'ssm_c_re': ssm_c_re[i], 'ssm_c_im': ssm_c_im[i],
            'ssm_d': ssm_d[i], 'ssm_log_dt': ssm_log_dt[i],
            'ssm_glu_w': ssm_glu_w[i], 'ssm_glu_b': ssm_glu_b[i], 'ssm_out_g': ssm_out_g[i],
            'w_out': w_out[i], 'norm_ffn_g': norm_ffn_g[i], 'ffn_w_up': ffn_w_up[i],
            'ffn_conv_w': ffn_conv_w[i], 'ffn_conv_b': ffn_conv_b[i], 'ffn_w_down': ffn_w_down[i],
            'norm_ple_g': norm_ple_g[i], 'ple_w_gate': ple_w_gate[i], 'ple_w_proj': ple_w_proj[i],
        }
        zero_h = jnp.zeros((hp.shape[0], N_SSM_GROUPS, SSM_STATE), jnp.float32)
        zero_c = jnp.zeros((hp.shape[0], CONV_W - 1, D_FF), hp.dtype)
        attend_p = functools.partial(prompt_diff_attention, table=rel_bias)
        attend_s = functools.partial(sample_diff_attention, table=rel_bias, k_pool=cache_k[i],
                                     v_pool=cache_v[i], page_table=page_table)
        hp, k1, v1, r1, m1, c1 = decoder_layer(hp, p_prompt[i], lp, i, attend_p, zero_h, zero_h, zero_c)
        hs, k2, v2, r2, m2, c2 = decoder_layer(hs, p_sample[i], lp, i, attend_s,
                                               state_ssm_re[i], state_ssm_im[i], state_conv[i])
        kp.append(k1); vp.append(v1); srp.append(r1); sip.append(m1); cp.append(c1)
        ks.append(k2); vs.append(v2); srs.append(r2); sis.append(m2); cs.append(c2)
    y_prompt = rmsnorm(hp, norm_final_g)
    y_sample = rmsnorm(hs, norm_final_g)
    return (y_prompt, y_sample,
            jnp.stack(kp), jnp.stack(vp), jnp.stack(srp), jnp.stack(sip), jnp.stack(cp),
            jnp.stack(ks), jnp.stack(vs), jnp.stack(srs), jnp.stack(sis), jnp.stack(cs))
```

```cpp
#include <hip/hip_runtime.h>
#include <hip/hip_bf16.h>
#include <cstdio>
#include <cstdint>
#include <cmath>
namespace pg8 {
#define PG8_LAS __attribute__((address_space(3)))
typedef unsigned short bf16_t;
typedef short bf16x8 __attribute__((ext_vector_type(8)));
typedef float f32x4 __attribute__((ext_vector_type(4)));
typedef unsigned u32x4 __attribute__((ext_vector_type(4)));
constexpr int BM = 256, BK = 64, HALF = 128, HTB = HALF * BK * 2  , STAGE_BYTES = 8 * HTB, NXCD = 8, WGM = 8;

__host__ __device__ __forceinline__ int lds_byte(int r, int c) { const int st = (r >> 4) * 2 + (c >> 5), rr = r & 15, cc = c & 31, ob = rr * 64 + cc * 2; return st * 1024 + (ob ^ (((ob >> 9) & 1) << 5)); }
__host__ __device__ __forceinline__ void stage_rc(int b, int& R, int& C) { const int st = b / 1024, sb = b % 1024, swz = sb ^ (((sb >> 9) & 1) << 5); R = (st >> 1) * 16 + swz / 64; C = (st & 1) * 32 + (swz % 64) / 2; }
__host__ __device__ __forceinline__ int perm32(int rho) { const int n = rho >> 4, i = rho & 15; return 8 * (i >> 2) + 4 * n + (i & 3); }

struct Unit { int pm, pn; };
struct Gemm { const bf16_t* A; const bf16_t* Bt; int M, N, K; };

struct StaticOrder {
    int nM, nN, nwg, G, c;
    __host__ __device__ void init(int M, int N, int G_, int c_) { nM = M / BM; nN = N / BM; nwg = nM * nN; G = G_; c = c_; }
    __host__ __device__ bool next(int i, Unit& u) const {
        const long L = (long)i * G + c; if (L >= nwg) return false;
        int wgid = (int)L; { const int q = nwg / NXCD, r = nwg % NXCD, xcd = wgid % NXCD, off = wgid / NXCD; wgid = (xcd < r ? xcd * (q + 1) : r * (q + 1) + (xcd - r) * q) + off; }
        const int nig = WGM * nN, gid = wgid / nig, fm = gid * WGM, gsz = (nM - fm) < WGM ? (nM - fm) : WGM;
        u.pm = fm + ((wgid % nig) % gsz); u.pn = (wgid % nig) / gsz; return true;
    }
    __device__ __forceinline__ void a_ready(const Unit&) const {}
    __device__ __forceinline__ void done(const Unit&) const {}
};

__device__ __forceinline__ unsigned cvt_pk_bf16(float lo, float hi) { unsigned r; asm volatile("v_cvt_pk_bf16_f32 %0, %1, %2" : "=v"(r) : "v"(lo), "v"(hi)); return r; }
typedef float f32x2 __attribute__((ext_vector_type(2)));
__device__ __forceinline__ f32x2 gelu_pk(f32x2 v) {
    const f32x2 av = __builtin_elementwise_abs(v), d = av * 0.2316418882f + 1.0f;
    f32x2 t; t.x = __builtin_amdgcn_rcpf(d.x); t.y = __builtin_amdgcn_rcpf(d.y);
    f32x2 q = t * 0.5307027145f + (-0.7265760135f); q = q * t + 0.7107068705f; q = q * t + (-0.142248368f); q = q * t + 0.127414796f; q = q * t;
    const f32x2 s = (v * v) * (-0.72134752044f);
    f32x2 e; e.x = __builtin_amdgcn_exp2f(s.x); e.y = __builtin_amdgcn_exp2f(s.y);
    const f32x2 m = v * (q * e), r = v - m;
    f32x2 o; o.x = v.x < 0.f ? m.x : r.x; o.y = v.y < 0.f ? m.y : r.y; return o;
}

constexpr float NORM_EPS_ = 1e-6f;
__device__ __forceinline__ u32x4 pack8(f32x4 a, f32x4 b) { u32x4 w; w.x = cvt_pk_bf16(a[0], a[1]); w.y = cvt_pk_bf16(a[2], a[3]); w.z = cvt_pk_bf16(b[0], b[1]); w.w = cvt_pk_bf16(b[2], b[3]); return w; }
__device__ __forceinline__ float rstd8(const float* ss) { const f32x4 a = *(const f32x4*)ss, b = *(const f32x4*)(ss + 4); return 1.0f / sqrtf((((a[0] + a[1]) + (a[2] + a[3])) + ((b[0] + b[1]) + (b[2] + b[3]))) * (1.0f / 2048.0f) + NORM_EPS_); }
__device__ __forceinline__ float bf_lo(unsigned w) { return __uint_as_float(w << 16); }
__device__ __forceinline__ float bf_hi(unsigned w) { return __uint_as_float(w & 0xffff0000u); }

struct EpiIn {
    static constexpr bool PERM = true, AFTER_DRAIN = false;
    const float* rstd; bf16_t* QB; bf16_t* KB; bf16_t* VB; float* US; float* Kout; float* Vout; float qscale;
    __device__ __forceinline__ void operator()(const f32x4 (&acc)[2][2][4][2], const Unit& u, int wr, int wc, int fr, int fq) const {
        const int row0 = u.pm * BM + wr * 64 + fr, sec = u.pn >> 2, col0 = (u.pn & 3) * BM + wc * 32 + 8 * fq;
#pragma unroll
        for (int ai = 0; ai < 2; ++ai)
#pragma unroll
            for (int m = 0; m < 4; ++m) { const int row = row0 + ai * HALF + m * 16; const float rs = rstd[row]; const size_t o = (size_t)row * 1024 + col0;
#pragma unroll
                for (int bj = 0; bj < 2; ++bj) { f32x4 v0 = acc[ai][bj][m][0] * rs, v1 = acc[ai][bj][m][1] * rs; const size_t oo = o + bj * HALF;
                    if (sec == 0) { v0 = v0 * qscale; v1 = v1 * qscale; *(u32x4*)(QB + oo) = pack8(v0, v1); }
                    else if (sec == 1) { *(f32x4*)(Kout + oo) = v0; *(f32x4*)(Kout + oo + 4) = v1; *(u32x4*)(KB + oo) = pack8(v0, v1); }
                    else if (sec == 2) { *(f32x4*)(Vout + oo) = v0; *(f32x4*)(Vout + oo + 4) = v1; *(u32x4*)(VB + oo) = pack8(v0, v1); }
                    else { *(f32x4*)(US + oo) = v0; *(f32x4*)(US + oo + 4) = v1; } } }
    }
};
struct EpiPlain {
    static constexpr bool PERM = true, AFTER_DRAIN = false;
    bf16_t* O; int ldc;
    __device__ __forceinline__ void operator()(const f32x4 (&acc)[2][2][4][2], const Unit& u, int wr, int wc, int fr, int fq) const {
        const int row0 = u.pm * BM + wr * 64 + fr, col0 = u.pn * BM + wc * 32 + 8 * fq;
#pragma unroll
        for (int ai = 0; ai < 2; ++ai)
#pragma unroll
            for (int m = 0; m < 4; ++m) { bf16_t* rowp = O + (size_t)(row0 + ai * HALF + m * 16) * ldc + col0;
#pragma unroll
                for (int bj = 0; bj < 2; ++bj) *(u32x4*)(rowp + bj * HALF) = pack8(acc[ai][bj][m][0], acc[ai][bj][m][1]); }
    }
};
struct EpiUp {
    static constexpr bool PERM = true, AFTER_DRAIN = false;
    const float* ssin; bf16_t* G; bf16_t* V2; float* conv_out; int ldf;
    __device__ __forceinline__ void operator()(const f32x4 (&acc)[2][2][4][2], const Unit& u, int wr, int wc, int fr, int fq) const {
        const int row0 = u.pm * BM + wr * 64 + fr, col0 = u.pn * HALF + wc * 32 + 8 * fq;
#pragma unroll
        for (int ai = 0; ai < 2; ++ai)
#pragma unroll
            for (int m = 0; m < 4; ++m) { const int row = row0 + ai * HALF + m * 16; const float rs = rstd8(ssin + (size_t)row * 8); const size_t o = (size_t)row * ldf + col0;
                const f32x4 g0 = acc[ai][0][m][0] * rs, g1 = acc[ai][0][m][1] * rs, v0 = acc[ai][1][m][0] * rs, v1 = acc[ai][1][m][1] * rs;
                *(u32x4*)(G + o) = pack8(g0, g1); *(u32x4*)(V2 + o) = pack8(v0, v1);
                const int tt = row & 4095;
                if (tt >= 4094) { float* co = conv_out + (size_t)((row >> 12) * 2 + (tt - 4094)) * ldf + col0; *(f32x4*)co = g0; *(f32x4*)(co + 4) = g1; } }
    }
};
template <int MODE> struct EpiRes {
    static constexpr bool PERM = true, AFTER_DRAIN = true;
    const float* base; float* outf; bf16_t* outb; float* ss; const float* ssin; const bf16_t* proj;
    __device__ __forceinline__ void fused(f32x4 (&acc)[2][2][4][2], const Unit& u, int wr, int wc, int fr, int fq, PG8_LAS unsigned char* lds, int wid, int lane) const {
        PG8_LAS float* P = (PG8_LAS float*)lds;
        const int col0 = u.pn * BM + wc * 32 + 8 * fq;
#pragma unroll
        for (int ai = 0; ai < 2; ++ai)
#pragma unroll
            for (int m = 0; m < 4; ++m) { const int rl = ai * HALF + wr * 64 + m * 16 + fr, row = u.pm * BM + rl; const size_t o = (size_t)row * 2048 + col0;
                float rs = 1.f; if (MODE == 1) rs = rstd8(ssin + (size_t)row * 8);
                float sq = 0.f;
#pragma unroll
                for (int bj = 0; bj < 2; ++bj) { const size_t oo = o + bj * HALF; f32x4 a0 = acc[ai][bj][m][0], a1 = acc[ai][bj][m][1];
                    const f32x4 b0 = *(const f32x4*)(base + oo), b1 = *(const f32x4*)(base + oo + 4);
                    if (MODE == 1) { const u32x4 pw = *(const u32x4*)(proj + oo);
                        const f32x4 p0 = {bf_lo(pw.x), bf_hi(pw.x), bf_lo(pw.y), bf_hi(pw.y)}, p1 = {bf_lo(pw.z), bf_hi(pw.z), bf_lo(pw.w), bf_hi(pw.w)};
#pragma unroll
                        for (int e = 0; e < 4; ++e) { a0[e] = p0[e] * __builtin_amdgcn_rcpf(1.f + __builtin_amdgcn_exp2f(-1.4426950408889634f * rs * a0[e])); a1[e] = p1[e] * __builtin_amdgcn_rcpf(1.f + __builtin_amdgcn_exp2f(-1.4426950408889634f * rs * a1[e])); } }
                    const f32x4 h0 = b0 + a0, h1 = b1 + a1;
                    *(f32x4*)(outf + oo) = h0; *(f32x4*)(outf + oo + 4) = h1;
                    if (outb) *(u32x4*)(outb + oo) = pack8(h0, h1);
                    sq += (h0[0] * h0[0] + h0[1] * h0[1]) + (h0[2] * h0[2] + h0[3] * h0[3]) + (h1[0] * h1[0] + h1[1] * h1[1]) + (h1[2] * h1[2] + h1[3] * h1[3]); }
                sq += __shfl_xor(sq, 16); sq += __shfl_xor(sq, 32);
                if (fq == 0) P[rl * 4 + wc] = sq; }
        asm volatile("s_waitcnt lgkmcnt(0)" ::: "memory"); __builtin_amdgcn_s_barrier(); asm volatile("" ::: "memory");
        const int t = wid * 64 + lane;
        if (t < 256) { const f32x4 p = *(const PG8_LAS f32x4*)(P + t * 4); ss[(size_t)(u.pm * BM + t) * 8 + u.pn] = (p[0] + p[1]) + (p[2] + p[3]); }
        asm volatile("s_waitcnt lgkmcnt(0)" ::: "memory"); __builtin_amdgcn_s_barrier(); asm volatile("" ::: "memory");
    }
};
template <class Epi, class Sched, bool ALIGN_EPI = false, bool SP2 = false>
__device__ __forceinline__ void gemm_phase(PG8_LAS unsigned char* lds, const Gemm g, const Sched& S, const Epi& E) {
    int tid_o = threadIdx.x; asm volatile("" : "+v"(tid_o));
    const int tid = tid_o, wid = __builtin_amdgcn_readfirstlane(tid >> 6), lane = tid & 63, wr = wid >> 2, wc = wid & 3, fr = lane & 15, fq = lane >> 4;
    const int K = g.K, nt = K / BK;
    unsigned voffA[2], voffB[2];
#pragma unroll
    for (int i = 0; i < 2; ++i) { int R, C; stage_rc(tid * 16 + i * 8192, R, C); const int Rb = Epi::PERM ? ((R & ~31) + perm32(R & 31)) : R;
        voffA[i] = (unsigned)(R * K + C) * 2u; voffB[i] = (unsigned)(Rb * K + C) * 2u; }
    const size_t kstep = (size_t)(BK * 2);
    const size_t hstep = (size_t)HALF * K * 2;
    const size_t tstep = 2 * hstep;
    const unsigned ldsw = (unsigned)wid * 1024u;
    const int aoff = lds_byte(wr * 64 + fr, fq * 8), boff = lds_byte(wc * 32 + fr, fq * 8);
#define PG8_SA(b, h) (((b) * 2 + (h)) * HTB)
#define PG8_SB(b, h) ((4 + (b) * 2 + (h)) * HTB)
#define PG8_STAGE(bufoff, gbase, voff) do { _Pragma("unroll") for (int _i = 0; _i < 2; ++_i) \
        __builtin_amdgcn_global_load_lds((const unsigned*)((const char*)(gbase) + (voff)[_i]), (PG8_LAS unsigned*)(lds + (bufoff) + ldsw + _i * 8192), 16, 0, 0); } while (0)
#define PG8_LDA(dst, b, h) do { _Pragma("unroll") for (int m = 0; m < 4; ++m) _Pragma("unroll") for (int k = 0; k < 2; ++k) dst[m][k] = *(const PG8_LAS bf16x8*)(lds + PG8_SA(b, h) + aoff + m * 2048 + k * 1024); } while (0)
#define PG8_LDB(dst, b, h) do { _Pragma("unroll") for (int n = 0; n < 2; ++n) _Pragma("unroll") for (int k = 0; k < 2; ++k) dst[n][k] = *(const PG8_LAS bf16x8*)(lds + PG8_SB(b, h) + boff + n * 2048 + k * 1024); } while (0)
#define PG8_MMA(ai, bj, At, Bt) do { __builtin_amdgcn_s_setprio(1); _Pragma("unroll") for (int m = 0; m < 4; ++m) _Pragma("unroll") for (int n = 0; n < 2; ++n) _Pragma("unroll") for (int k = 0; k < 2; ++k) \
        acc[ai][bj][m][n] = __builtin_amdgcn_mfma_f32_16x16x32_bf16(Bt[n][k], At[m][k], acc[ai][bj][m][n], 0, 0, 0); __builtin_amdgcn_s_setprio(0); } while (0)
#define PG8_WAIT_V(n) asm volatile("s_waitcnt vmcnt(" #n ")" ::: "memory")
#define PG8_WAIT_L(n) asm volatile("s_waitcnt lgkmcnt(" #n ")" ::: "memory")
#define PG8_BAR __builtin_amdgcn_s_barrier()
#define PG8_SCHED __builtin_amdgcn_sched_barrier(0)
    Unit cur, nxt; int ui = 0;
    if (!S.next(0, cur)) return;
    f32x4 acc[2][2][4][2];
#pragma unroll
    for (int a = 0; a < 2; ++a)
#pragma unroll
        for (int b = 0; b < 2; ++b)
#pragma unroll
            for (int m = 0; m < 4; ++m)
#pragma unroll
                for (int n = 0; n < 2; ++n) acc[a][b][m][n] = (f32x4){0.f, 0.f, 0.f, 0.f};
    bf16x8 At[4][2], B0[2][2], B1[2][2];
    const char* cA = (const char*)g.A + (size_t)cur.pm * tstep; const char* cB = (const char*)g.Bt + (size_t)cur.pn * tstep;
    S.a_ready(cur);
    if constexpr (SP2) {
        PG8_STAGE(PG8_SB(0, 0), cB, voffB); PG8_STAGE(PG8_SB(0, 1), cB + hstep, voffB); PG8_STAGE(PG8_SA(0, 0), cA, voffA); PG8_STAGE(PG8_SA(0, 1), cA + hstep, voffA);
        if (wr == 1) PG8_BAR;
        PG8_WAIT_V(2); PG8_BAR;
        PG8_STAGE(PG8_SB(1, 0), cB + kstep, voffB); PG8_STAGE(PG8_SA(1, 0), cA + kstep, voffA); PG8_STAGE(PG8_SB(1, 1), cB + hstep + kstep, voffB);
        PG8_WAIT_V(6); PG8_BAR;
    } else {
        PG8_STAGE(PG8_SB(0, 0), cB, voffB); PG8_STAGE(PG8_SA(0, 0), cA, voffA); PG8_STAGE(PG8_SB(0, 1), cB + hstep, voffB); PG8_STAGE(PG8_SA(0, 1), cA + hstep, voffA);
        if (wr == 1) PG8_BAR;
        PG8_WAIT_V(4); PG8_BAR;
        PG8_STAGE(PG8_SB(1, 0), cB + kstep, voffB); PG8_STAGE(PG8_SA(1, 0), cA + kstep, voffA); PG8_STAGE(PG8_SB(1, 1), cB + hstep + kstep, voffB);
        PG8_WAIT_V(6); PG8_BAR;
    }
    for (;;) {
        const bool has_next = S.next(ui + 1, nxt);
        const char* nA = has_next ? (const char*)g.A + (size_t)nxt.pm * tstep : cA; const char* nB = has_next ? (const char*)g.Bt + (size_t)nxt.pn * tstep : cB;
        for (int t = 0; t < nt; t += 2) {
            const bool last = (t == nt - 2);
            const char* a1 = cA + (size_t)(t + 1) * kstep;
            const char* a2 = last ? nA : cA + (size_t)(t + 2) * kstep; const char* b2 = last ? nB : cB + (size_t)(t + 2) * kstep;
            const char* a3 = a2 + kstep; const char* b3 = b2 + kstep;
            if (last && has_next) S.a_ready(nxt);
            if constexpr (SP2) {
            PG8_LDB(B0, 0, 0); PG8_LDB(B1, 0, 1); PG8_SCHED; PG8_LDA(At, 0, 0); PG8_STAGE(PG8_SA(1, 1), a1 + hstep, voffA);
            PG8_WAIT_V(8); PG8_WAIT_L(0); PG8_BAR; PG8_MMA(0, 0, At, B0); PG8_MMA(0, 1, At, B1); PG8_BAR; PG8_SCHED;
            PG8_LDA(At, 0, 1); PG8_STAGE(PG8_SB(0, 0), b2, voffB); PG8_STAGE(PG8_SB(0, 1), b2 + hstep, voffB); PG8_STAGE(PG8_SA(0, 0), a2, voffA);
            PG8_WAIT_V(8); PG8_WAIT_L(0); PG8_BAR; PG8_MMA(1, 0, At, B0); PG8_MMA(1, 1, At, B1); PG8_BAR; PG8_SCHED;
            PG8_LDB(B0, 1, 0); PG8_LDB(B1, 1, 1); PG8_SCHED; PG8_LDA(At, 1, 0); PG8_STAGE(PG8_SA(0, 1), a2 + hstep, voffA);
            PG8_WAIT_V(8); PG8_WAIT_L(0); PG8_BAR; PG8_MMA(0, 0, At, B0); PG8_MMA(0, 1, At, B1); PG8_BAR; PG8_SCHED;
            PG8_LDA(At, 1, 1); PG8_STAGE(PG8_SB(1, 0), b3, voffB); PG8_STAGE(PG8_SB(1, 1), b3 + hstep, voffB); PG8_STAGE(PG8_SA(1, 0), a3, voffA);
            PG8_WAIT_V(8); PG8_WAIT_L(0); PG8_BAR; PG8_MMA(1, 0, At, B0); PG8_MMA(1, 1, At, B1); PG8_BAR; PG8_SCHED;
            } else {
            PG8_LDB(B0, 0, 0); PG8_SCHED; PG8_LDA(At, 0, 0); PG8_STAGE(PG8_SA(1, 1), a1 + hstep, voffA);
            PG8_WAIT_L(8); PG8_BAR; PG8_WAIT_L(0); PG8_MMA(0, 0, At, B0); PG8_BAR; PG8_SCHED;
            PG8_LDB(B1, 0, 1); PG8_STAGE(PG8_SB(0, 0), b2, voffB);
            PG8_BAR; PG8_WAIT_L(0); PG8_MMA(0, 1, At, B1); PG8_BAR;
            PG8_LDA(At, 0, 1); PG8_STAGE(PG8_SA(0, 0), a2, voffA);
            PG8_BAR; PG8_WAIT_L(0); PG8_MMA(1, 0, At, B0); PG8_BAR; PG8_SCHED;
            PG8_STAGE(PG8_SB(0, 1), b2 + hstep, voffB);
            PG8_WAIT_V(6); PG8_BAR; PG8_MMA(1, 1, At, B1); PG8_BAR;
            PG8_LDB(B0, 1, 0); PG8_SCHED; PG8_LDA(At, 1, 0); PG8_STAGE(PG8_SA(0, 1), a2 + hstep, voffA);
            PG8_WAIT_L(8); PG8_BAR; PG8_WAIT_L(0); PG8_MMA(0, 0, At, B0); PG8_BAR; PG8_SCHED;
            PG8_LDB(B1, 1, 1); PG8_STAGE(PG8_SB(1, 0), b3, voffB);
            PG8_BAR; PG8_WAIT_L(0); PG8_MMA(0, 1, At, B1); PG8_BAR;
            PG8_LDA(At, 1, 1); PG8_STAGE(PG8_SA(1, 0), a3, voffA);
            PG8_BAR; PG8_WAIT_L(0); PG8_MMA(1, 0, At, B0); PG8_BAR; PG8_SCHED;
            PG8_STAGE(PG8_SB(1, 1), b3 + hstep, voffB);
            PG8_WAIT_V(6); PG8_BAR; PG8_MMA(1, 1, At, B1); PG8_BAR;
            }
        }
        if constexpr (ALIGN_EPI) { if (wr == 0) PG8_BAR; }
        if constexpr (!Epi::AFTER_DRAIN) { E(acc, cur, wr, wc, fr, fq); S.done(cur); }
        if (!has_next) break;
#pragma unroll
        for (int a = 0; a < 2; ++a)
#pragma unroll
            for (int b = 0; b < 2; ++b)
#pragma unroll
                for (int m = 0; m < 4; ++m)
#pragma unroll
                    for (int n = 0; n < 2; ++n) acc[a][b][m][n] = (f32x4){0.f, 0.f, 0.f, 0.f};
        cur = nxt; cA = nA; cB = nB; ++ui;
        if constexpr (ALIGN_EPI) { if (wr == 1) PG8_BAR; }
    }
    PG8_WAIT_V(0);
    if constexpr (!ALIGN_EPI) { if (wr == 0) PG8_BAR; }
    PG8_BAR;
    if constexpr (Epi::AFTER_DRAIN) { E.fused(acc, cur, wr, wc, fr, fq, lds, wid, lane); S.done(cur); }
#undef PG8_SA
#undef PG8_SB
#undef PG8_STAGE
#undef PG8_LDA
#undef PG8_LDB
#undef PG8_MMA
#undef PG8_WAIT_V
#undef PG8_WAIT_L
#undef PG8_BAR
#undef PG8_SCHED
}
}
namespace attn_body {
using bf16=__hip_bfloat16;
using bf16x8=__attribute__((ext_vector_type(8)))short;
using s16x4=__attribute__((ext_vector_type(4)))short;
using f32x16=__attribute__((ext_vector_type(16)))float;
using u32x4=__attribute__((ext_vector_type(4)))unsigned;
constexpr int BATCH=2,NHEAD=16,SEQ=4096,D=64,DM=NHEAD*D;
constexpr int NW=8,QBLK=32,QB=QBLK*NW,KVBLK=64,NQB=SEQ/QB;
constexpr int ATTN_PITCH=DM, ATTN_UNIT_ROWS=QB;
__device__ __forceinline__ int crow(int r,int hi){return (r&3)+8*(r>>2)+4*hi;}
#define SBAR() __builtin_amdgcn_sched_barrier(0)
__device__ __forceinline__ void cmask(f32x16&p0,f32x16&p1,int jb,int qrel,int hi){
  const float NEG=-INFINITY; int kb=64*jb+4*hi;
  #pragma unroll
  for(int r=0;r<16;++r){int kv=kb+(r&3)+8*(r>>2); if(kv>qrel)p0[r]=NEG; if(kv+32>qrel)p1[r]=NEG;}
}

typedef __attribute__((address_space(3))) const float* lds_cfptr;
__device__ __forceinline__ void bmask(f32x16&p0,f32x16&p1,int t,int qabs,int hi,lds_cfptr lutx){
  const lds_cfptr p=lutx+(qabs-64*t-4*hi+256-59);
  #pragma unroll
  for(int r=0;r<16;++r){ const int k=(r&3)+8*(r>>2); const float a=p[59-k], b=p[59-k-32]; asm volatile("v_add_f32 %0, %0, %1":"+v"(p0[r]):"v"(a)); asm volatile("v_add_f32 %0, %0, %1":"+v"(p1[r]):"v"(b)); }
}
constexpr int NSLOT=3, SLOTB=8192;
constexpr int LDS_K=0, LDS_V=NSLOT*SLOTB, LDS_WS=2*NSLOT*SLOTB, LDS_OST=LDS_WS+NW*64*4, LDS_BYTES=LDS_OST+NW*4096;
constexpr float C2=0.125f*1.4426950408889634f;
__device__ __forceinline__ void glds16(const void*gsrc,unsigned lds_dst){unsigned keep;
  asm volatile("s_mov_b32 %0, m0\n\ts_mov_b32 m0, %2\n\ts_nop 0\n\tglobal_load_lds_dwordx4 %1, off\n\ts_mov_b32 m0, %0":"=&s"(keep):"v"(gsrc),"s"(lds_dst):"memory");}
__device__ __forceinline__ float max3f(float a,float b,float c){float r;asm("v_max3_f32 %0, %1, %2, %3":"=v"(r):"v"(a),"v"(b),"v"(c));return r;}
__device__ __forceinline__ float max2f(float a,float b){float r;asm("v_max_f32_e32 %0, %1, %2":"=v"(r):"v"(a),"v"(b));return r;}
__device__ __forceinline__ float fadd_s(float a,float b){float r;asm("v_add_f32_e32 %0, %1, %2":"=v"(r):"v"(a),"v"(b));return r;}
__device__ __forceinline__ float fsub_s(float a,float b){float r;asm("v_sub_f32_e32 %0, %1, %2":"=v"(r):"v"(a),"v"(b));return r;}
typedef float f32x2_t __attribute__((ext_vector_type(2))); typedef __bf16 bf16x2_t __attribute__((ext_vector_type(2)));
__device__ __forceinline__ unsigned cvtpk_s(float lo,float hi){f32x2_t v={lo,hi};bf16x2_t b=__builtin_convertvector(v,bf16x2_t);return __builtin_bit_cast(unsigned,b);}
#define WAIT_BAR(N) asm volatile("s_waitcnt vmcnt(" #N ") lgkmcnt(0)\n\ts_barrier":::"memory")

__device__ __forceinline__ void qkt(f32x16&p0,f32x16&p1,const char*Kslot,const bf16x8*qr,const f32x16&negm,int r32,int hi){
  const char*kb=Kslot+hi*1024+r32*16;
  #pragma unroll
  for(int d0=0;d0<4;++d0){
    const bf16x8 b0=*reinterpret_cast<const bf16x8*>(kb+d0*2048);
    const bf16x8 b1=*reinterpret_cast<const bf16x8*>(kb+d0*2048+512);
    if(d0==0){p0=__builtin_amdgcn_mfma_f32_32x32x16_bf16(b0,qr[0],negm,0,0,0);p1=__builtin_amdgcn_mfma_f32_32x32x16_bf16(b1,qr[0],negm,0,0,0);}
    else{p0=__builtin_amdgcn_mfma_f32_32x32x16_bf16(b0,qr[d0],p0,0,0,0);p1=__builtin_amdgcn_mfma_f32_32x32x16_bf16(b1,qr[d0],p1,0,0,0);}}
}
typedef __attribute__((address_space(3))) const char* lds_cptr;
typedef short v4i16_t __attribute__((ext_vector_type(4)));
__device__ __forceinline__ void kload8(bf16x8*kf,lds_cptr kp){
  kf[0]=*(const __attribute__((address_space(3))) bf16x8*)(kp);      kf[1]=*(const __attribute__((address_space(3))) bf16x8*)(kp+512);
  kf[2]=*(const __attribute__((address_space(3))) bf16x8*)(kp+2048); kf[3]=*(const __attribute__((address_space(3))) bf16x8*)(kp+2560);
  kf[4]=*(const __attribute__((address_space(3))) bf16x8*)(kp+4096); kf[5]=*(const __attribute__((address_space(3))) bf16x8*)(kp+4608);
  kf[6]=*(const __attribute__((address_space(3))) bf16x8*)(kp+6144); kf[7]=*(const __attribute__((address_space(3))) bf16x8*)(kp+6656);
}
__device__ __forceinline__ void kload2(bf16x8*kf,lds_cptr kp,int j){ kf[2*j]=*(const __attribute__((address_space(3))) bf16x8*)(kp+j*2048); kf[2*j+1]=*(const __attribute__((address_space(3))) bf16x8*)(kp+j*2048+512); }
__device__ __forceinline__ s16x4 vtr(lds_cptr p){ return __builtin_bit_cast(s16x4,__builtin_amdgcn_ds_read_tr16_b64_v4i16((__attribute__((address_space(3))) v4i16_t*)p)); }
__device__ __forceinline__ float rowmax(const f32x16&p0,const f32x16&p1){
  float a=max3f(p0[0],p0[1],p1[0]),b=max3f(p0[2],p0[3],p1[1]);a=max3f(a,p1[2],p1[3]);
  #pragma unroll
  for(int r=4;r<16;r+=4){a=max3f(a,p0[r],p0[r+1]);b=max3f(b,p0[r+2],p0[r+3]);a=max3f(a,p1[r],p1[r+1]);b=max3f(b,p1[r+2],p1[r+3]);}
  const float m=max2f(a,b);
  auto rr=__builtin_amdgcn_permlane32_swap(__float_as_uint(m),__float_as_uint(m),false,false);
  return max2f(__uint_as_float(rr[0]),__uint_as_float(rr[1]));
}
__device__ __forceinline__ void pv(f32x16*o,int vb,bf16x8 pa0,bf16x8 pa1,bf16x8 pa2,bf16x8 pa3){
  #pragma unroll
  for(int d0=0;d0<2;++d0){s16x4 lo[4],hi[4];
    #pragma unroll
    for(int ks=0;ks<4;++ks){
      asm volatile("ds_read_b64_tr_b16 %0,%1 offset:%c2":"=&v"(lo[ks]):"v"(vb),"i"(d0*4096+ks*1024):"memory");
      asm volatile("ds_read_b64_tr_b16 %0,%1 offset:%c2":"=&v"(hi[ks]):"v"(vb),"i"(d0*4096+ks*1024+512):"memory");}
    asm volatile("s_waitcnt lgkmcnt(0)":::"memory");SBAR();
    #define PK(k) (bf16x8){lo[k][0],lo[k][1],lo[k][2],lo[k][3],hi[k][0],hi[k][1],hi[k][2],hi[k][3]}
    o[d0]=__builtin_amdgcn_mfma_f32_32x32x16_bf16(pa0,PK(0),o[d0],0,0,0);
    o[d0]=__builtin_amdgcn_mfma_f32_32x32x16_bf16(pa1,PK(1),o[d0],0,0,0);
    o[d0]=__builtin_amdgcn_mfma_f32_32x32x16_bf16(pa2,PK(2),o[d0],0,0,0);
    o[d0]=__builtin_amdgcn_mfma_f32_32x32x16_bf16(pa3,PK(3),o[d0],0,0,0);
    #undef PK
  }
}

#ifndef ATTN_STORE16
#define ATTN_STORE16(p,v) (*(u32x4*)(p)=(v))
#endif
template<int THRL> __device__ __forceinline__ void attn_unit(int b,int hq,int hv,int qb,const bf16*Q,const bf16*__restrict__ K,const bf16*__restrict__ V,bf16*O,char*shm,lds_cfptr lut){
  int tid_o=threadIdx.x; asm volatile("":"+v"(tid_o)); const int tid=tid_o,lane=tid&63,r32=lane&31,hi=lane>>5; const int wid=__builtin_amdgcn_readfirstlane(tid>>6);
  const long rowbase=(long)b*SEQ; const int q0=qb*QB;
  const bf16*Qw=Q+(rowbase+q0+wid*QBLK)*DM+hq*D;
  const bf16*Kh=K+rowbase*DM+hq*D,*Vh=V+rowbase*DM+hv*D;
  const unsigned lds0=(unsigned)(uintptr_t)shm;
  float*wsf=(float*)(shm+LDS_WS)+wid*64;
  const bf16*ksrc=Kh+(long)lane*DM+wid*8;
  const bf16*vsrc=Vh+(long)(16*(wid&3)+(lane>>2))*DM+(wid>>2)*32+(lane&3)*8;
  const unsigned kdst=lds0+LDS_K+wid*1024, vdst=lds0+LDS_V+wid*1024;
  #define DMA_K(t,slot) glds16(ksrc+(long)(t)*KVBLK*DM,(unsigned)__builtin_amdgcn_readfirstlane(kdst+(slot)))
  #define DMA_V(t,slot) glds16(vsrc+(long)(t)*KVBLK*DM,(unsigned)__builtin_amdgcn_readfirstlane(vdst+(slot)))
  const int vb0=(int)(lds0+LDS_V)+((lane>>4)&1)*32+(lane&3)*8+(4*hi+((lane&15)>>2))*64;
  const char*Kbase=shm+LDS_K; bf16x8 kf[8];
  const lds_cptr shm3=(lds_cptr)shm; const lds_cptr kp0=shm3+LDS_K+hi*1024+r32*16; const lds_cptr vp0=shm3+LDS_V+((lane>>4)&1)*32+(lane&3)*8+(4*hi+((lane&15)>>2))*64;
  const int NT=(q0+QB)/KVBLK;
  DMA_K(0,0);DMA_V(0,0);DMA_K(1,SLOTB);
  bf16x8 qr[4];
  #pragma unroll
  for(int d0=0;d0<4;++d0)qr[d0]=*reinterpret_cast<const bf16x8*>(&Qw[(long)r32*DM+d0*16+hi*8]);
  float mhat=0.f,l_reg=0.f;f32x16 o[2];o[0]=f32x16{};o[1]=f32x16{};f32x16 negm=f32x16{};asm volatile("":"+v"(negm));
  const int qrel=wid*QBLK+r32;
  #define CMASK(P0,P1,t) do{ if((t)>=NT-6) bmask(P0,P1,(t),q0+qrel,hi,lut); }while(0)
  bool resc=false;
  #define START(P0,P1) do{ const float rm=rowmax(P0,P1); resc=false; \
    { const float dl=rm; mhat=fadd_s(mhat,dl); \
      _Pragma("unroll") for(int r=0;r<16;++r){P0[r]=fsub_s(P0[r],dl);P1[r]=fsub_s(P1[r],dl);} \
      _Pragma("unroll") for(int r=0;r<16;++r)negm[r]=-mhat; asm volatile("":"+v"(negm)); } \
    _Pragma("unroll") for(int r=0;r<16;++r)P0[r]=__builtin_amdgcn_exp2f(P0[r]); }while(0)
  #define RESC() do{ if(resc){ asm volatile("s_waitcnt lgkmcnt(0)":::"memory"); \
      _Pragma("unroll") for(int d_=0;d_<2;++d_) _Pragma("unroll") for(int r=0;r<16;++r)o[d_][r]*=wsf[crow(r,hi)]; } }while(0)
  f32x16 pA0,pA1,pB0,pB1;
  int sl_prev=0,sl_cur=0,sl_next=SLOTB;
  #define ROT() do{sl_prev=sl_cur;sl_cur=sl_next;sl_next=(sl_next==(NSLOT-1)*SLOTB)?0:sl_next+SLOTB;}while(0)
  DMA_K(2,2*SLOTB);
  WAIT_BAR(3);
  qkt(pA0,pA1,Kbase,qr,negm,r32,hi);asm volatile("s_nop 15\n\ts_nop 7":"+v"(pA0),"+v"(pA1));CMASK(pA0,pA1,0);
  START(pA0,pA1);
  _Pragma("unroll") for(int r=0;r<16;++r)pA1[r]=__builtin_amdgcn_exp2f(pA1[r]);
  WAIT_BAR(0);
  DMA_K(3,0);DMA_V(1,SLOTB);
  ROT();
  kload8(kf,kp0+sl_cur);
  WAIT_BAR(2);
  s16x4 vlo[8],vhi[8]; u32x4 pw0,pw1,pw2,pw3;
  #define PKW(P,B) cvtpk_s(P[B],P[B+1])
  #define PAF(k) __builtin_bit_cast(bf16x8,pw##k)
  #define VFR(i) (bf16x8){vlo[i][0],vlo[i][1],vlo[i][2],vlo[i][3],vhi[i][0],vhi[i][1],vhi[i][2],vhi[i][3]}
  #define PIN(x) asm volatile("":"+v"(x))
  #define MX3(a,b,c) __builtin_fmaxf(__builtin_fmaxf((a),(b)),(c))
  #define GAPA(MF,A0,A1,A2,A3,W0,W1,PW) do{ MF; sacc+=A0; sacc+=A1; sacc+=A2; sacc+=A3; PIN(sacc); W0; W1; PIN(PW); SBAR(); }while(0)
  #define EX(v) __builtin_amdgcn_exp2f(v)
  #define GAPB(MF,X,B) do{ MF; X[B]=EX(X[B]); X[B+1]=EX(X[B+1]); X[B+2]=EX(X[B+2]); X[B+3]=EX(X[B+3]); PIN(X); SBAR(); }while(0)
  #define VRD(i) do{ vlo[i]=vtr(vp_+(((i)>>2)*4096+((i)&3)*1024)); vhi[i]=vtr(vp_+(((i)>>2)*4096+((i)&3)*1024+512)); }while(0)
  #define KRD(G,j) do{ if(G){ kload2(kf,kp0+sl_next,j); SBAR(); } }while(0)
  #define STEP(C0,C1,P0,P1,t,GK,GV,GL) do{ SBAR(); \
    const lds_cptr vp_=vp0+sl_prev; \
    VRD(0); SBAR(); float sacc=(P0[0]+P0[1]); \
    GAPA(C0=__builtin_amdgcn_mfma_f32_32x32x16_bf16(kf[0],qr[0],negm,0,0,0), P0[2],P0[3],P0[4],P0[5],     pw0[0]=PKW(P0,0), pw0[1]=PKW(P0,2), pw0); \
    VRD(4); SBAR(); GAPA(C1=__builtin_amdgcn_mfma_f32_32x32x16_bf16(kf[1],qr[0],negm,0,0,0), P0[6],P0[7],P0[8],P0[9],     pw0[2]=PKW(P0,4), pw0[3]=PKW(P0,6), pw0); \
    VRD(1); SBAR(); GAPA(C0=__builtin_amdgcn_mfma_f32_32x32x16_bf16(kf[2],qr[1],C0,0,0,0),   P0[10],P0[11],P0[12],P0[13], pw1[0]=PKW(P0,8), pw1[1]=PKW(P0,10), pw1); \
    VRD(5); SBAR(); GAPA(C1=__builtin_amdgcn_mfma_f32_32x32x16_bf16(kf[3],qr[1],C1,0,0,0),   P0[14],P0[15],P1[0],P1[1],   pw1[2]=PKW(P0,12),pw1[3]=PKW(P0,14), pw1); \
    VRD(2); SBAR(); GAPA(C0=__builtin_amdgcn_mfma_f32_32x32x16_bf16(kf[4],qr[2],C0,0,0,0),   P1[2],P1[3],P1[4],P1[5],     pw2[0]=PKW(P1,0), pw2[1]=PKW(P1,2), pw2); \
    VRD(6); SBAR(); GAPA(C1=__builtin_amdgcn_mfma_f32_32x32x16_bf16(kf[5],qr[2],C1,0,0,0),   P1[6],P1[7],P1[8],P1[9],     pw2[2]=PKW(P1,4), pw2[3]=PKW(P1,6), pw2); \
    VRD(3); SBAR(); GAPA(C0=__builtin_amdgcn_mfma_f32_32x32x16_bf16(kf[6],qr[3],C0,0,0,0),   P1[10],P1[11],P1[12],P1[13], pw3[0]=PKW(P1,8), pw3[1]=PKW(P1,10), pw3); \
    VRD(7); SBAR(); GAPA(C1=__builtin_amdgcn_mfma_f32_32x32x16_bf16(kf[7],qr[3],C1,0,0,0),   P1[14],P1[15],0.f,0.f,       pw3[2]=PKW(P1,12),pw3[3]=PKW(P1,14), pw3); \
    asm volatile("s_nop 15\n\ts_nop 7":"+v"(C0),"+v"(C1));   \
    l_reg+=sacc; \
    if(GK){DMA_K((t)+3,sl_cur);} if(GV){DMA_V((t)+1,sl_next);} \
    CMASK(C0,C1,t); \
    { float a=MX3(C0[0],C0[1],C1[0]),b=MX3(C0[2],C0[3],C1[1]); a=MX3(a,C1[2],C1[3]); \
      _Pragma("unroll") for(int r=4;r<16;r+=4){a=MX3(a,C0[r],C0[r+1]);b=MX3(b,C0[r+2],C0[r+3]);a=MX3(a,C1[r],C1[r+1]);b=MX3(b,C1[r+2],C1[r+3]);} \
      float rm=__builtin_fmaxf(a,b); { auto rr=__builtin_amdgcn_permlane32_swap(__float_as_uint(rm),__float_as_uint(rm),false,false); rm=__builtin_fmaxf(__uint_as_float(rr[0]),__uint_as_float(rr[1])); } \
      resc=false; \
      if(__builtin_expect(__any(rm>(float)THRL),0)){ const float dl=__builtin_fmaxf(rm,0.f); mhat+=dl; \
        _Pragma("unroll") for(int r=0;r<16;++r){C0[r]-=dl;C1[r]-=dl;} \
        _Pragma("unroll") for(int r=0;r<16;++r)negm[r]=-mhat; asm volatile("":"+v"(negm)); \
        const float f=__builtin_amdgcn_exp2f(-dl); l_reg*=f; if(hi==0)wsf[r32]=f; resc=true; } } \
    SBAR(); \
    GAPB(o[0]=__builtin_amdgcn_mfma_f32_32x32x16_bf16(PAF(0),VFR(0),o[0],0,0,0), C0,0); \
    GAPB(o[1]=__builtin_amdgcn_mfma_f32_32x32x16_bf16(PAF(0),VFR(4),o[1],0,0,0), C0,4); \
    KRD(GL,0); GAPB(o[0]=__builtin_amdgcn_mfma_f32_32x32x16_bf16(PAF(1),VFR(1),o[0],0,0,0), C0,8); \
    KRD(GL,1); GAPB(o[1]=__builtin_amdgcn_mfma_f32_32x32x16_bf16(PAF(1),VFR(5),o[1],0,0,0), C0,12); \
    KRD(GL,2); GAPB(o[0]=__builtin_amdgcn_mfma_f32_32x32x16_bf16(PAF(2),VFR(2),o[0],0,0,0), C1,0); \
    KRD(GL,3); GAPB(o[1]=__builtin_amdgcn_mfma_f32_32x32x16_bf16(PAF(2),VFR(6),o[1],0,0,0), C1,4); \
    GAPB(o[0]=__builtin_amdgcn_mfma_f32_32x32x16_bf16(PAF(3),VFR(3),o[0],0,0,0), C1,8); \
    GAPB(o[1]=__builtin_amdgcn_mfma_f32_32x32x16_bf16(PAF(3),VFR(7),o[1],0,0,0), C1,12); \
    }while(0)
  int t=1;
  #undef CMASK
  #define CMASK(P0,P1,t) do{}while(0)
  for(;t+7<NT;t+=2){
    STEP(pB0,pB1,pA0,pA1,t,true,true,true);     WAIT_BAR(2); RESC(); ROT();
    STEP(pA0,pA1,pB0,pB1,t+1,true,true,true);   WAIT_BAR(2); RESC(); ROT();
  }
  #undef CMASK
  #define CMASK(P0,P1,t) do{ if((t)>=NT-6) bmask(P0,P1,(t),q0+qrel,hi,lut); }while(0)
  #define ENDW(tt) do{ if((tt)+3<NT){WAIT_BAR(2);} else if((tt)+2<NT){WAIT_BAR(1);} else {WAIT_BAR(0);} }while(0)
  for(;t+1<NT;t+=2){
    STEP(pB0,pB1,pA0,pA1,t,(t+3<NT),(t+1<NT),(t+1<NT));       ENDW(t);   RESC(); ROT();
    STEP(pA0,pA1,pB0,pB1,t+1,(t+4<NT),(t+2<NT),(t+2<NT));     ENDW(t+1); RESC(); ROT();
  }
  STEP(pB0,pB1,pA0,pA1,NT-1,false,false,false); RESC();
  { float sacc=pB0[0]+pB0[1]; _Pragma("unroll") for(int r=2;r<16;++r)sacc+=pB0[r]; _Pragma("unroll") for(int r=0;r<16;++r)sacc+=pB1[r]; l_reg+=sacc;
    pw0=(u32x4){PKW(pB0,0),PKW(pB0,2),PKW(pB0,4),PKW(pB0,6)};pw1=(u32x4){PKW(pB0,8),PKW(pB0,10),PKW(pB0,12),PKW(pB0,14)};pw2=(u32x4){PKW(pB1,0),PKW(pB1,2),PKW(pB1,4),PKW(pB1,6)};pw3=(u32x4){PKW(pB1,8),PKW(pB1,10),PKW(pB1,12),PKW(pB1,14)};
    SBAR(); pv(o,vb0+sl_cur,PAF(0),PAF(1),PAF(2),PAF(3)); }
  #undef PKW
  #undef PAF
  #undef VFR
  #undef PIN
  #undef MX3
  #undef GAPA
  #undef GAPB
  #undef EX
  #undef VRD
  #undef KRD
  #undef STEP
  #undef ENDW
  {auto rr=__builtin_amdgcn_permlane32_swap(__float_as_uint(l_reg),__float_as_uint(l_reg),false,false);l_reg=__uint_as_float(rr[0])+__uint_as_float(rr[1]);}
  if(hi==0)wsf[32+r32]=l_reg;asm volatile("s_waitcnt lgkmcnt(0)":::"memory");
  float rli[16];
  #pragma unroll
  for(int r=0;r<16;++r)rli[r]=__builtin_amdgcn_rcpf(wsf[32+crow(r,hi)]);
  bf16*Ow=O+(rowbase+q0+wid*QBLK)*DM+hv*D;
  { bf16*stg=(bf16*)(shm+LDS_OST)+wid*2048;
    #pragma unroll
    for(int r=0;r<16;++r){const int orow=crow(r,hi);
      #pragma unroll
      for(int d0=0;d0<2;++d0)stg[orow*64+d0*32+r32]=__float2bfloat16(o[d0][r]*rli[r]);}
    asm volatile("s_waitcnt lgkmcnt(0)":::"memory");
    #pragma unroll
    for(int i=0;i<4;++i){const int row=i*8+(lane>>3),ch=lane&7; const u32x4 v=*(const u32x4*)(stg+row*64+ch*8); ATTN_STORE16(Ow+(long)row*DM+ch*8,v);} }
  asm volatile("s_waitcnt lgkmcnt(0)\n\ts_barrier":::"memory");
  #undef DMA_K
  #undef DMA_V
  #undef CMASK
  #undef START
  #undef RESC
  #undef ROT
}
constexpr int ATTN_LDS_BYTES=LDS_BYTES;

#undef SBAR
#undef WAIT_BAR
}
#define GAS __attribute__((address_space(1)))
#define LAS __attribute__((address_space(3)))
typedef unsigned short bf16;
typedef unsigned v4u __attribute__((ext_vector_type(4)));
typedef float f32x4 __attribute__((ext_vector_type(4)));
typedef short bf16x8 __attribute__((ext_vector_type(8)));
typedef GAS unsigned gu32;
typedef GAS unsigned long long gu64;
#define RLX_AGENT __ATOMIC_RELAXED, __HIP_MEMORY_SCOPE_AGENT
#define LDS_WAIT() asm volatile("s_waitcnt lgkmcnt(0)" ::: "memory")
#define VM_WAIT() asm volatile("s_waitcnt vmcnt(0)" ::: "memory")
__device__ __forceinline__ unsigned long long rt() { return __builtin_amdgcn_s_memrealtime(); }
__device__ __forceinline__ unsigned f2bf(float f) { unsigned u = __builtin_bit_cast(unsigned, f); return (u + 0x7fffu + ((u >> 16) & 1u)) >> 16; }
__device__ __forceinline__ unsigned pk2(float lo, float hi) { return f2bf(lo) | (f2bf(hi) << 16); }

#define XB_TMO      128
#define XB_XCNT(j)  (256  + 64 * (j))
#define XB_XSUB(j)  (1280 + 64 * (j))
#define XB_XGEN(j)  (2304 + 64 * (j))
#define XB_TOP      3328
#define XB_TOPGEN   3392
#define XCD_BAR_WORDS 3456
#define XB_SPIN_CAP (1u << 18)

__device__ __forceinline__ unsigned xb_ld(unsigned* p)              { return __hip_atomic_load(p, __ATOMIC_RELAXED, __HIP_MEMORY_SCOPE_AGENT); }
__device__ __forceinline__ unsigned xb_add(unsigned* p, unsigned v) { return __hip_atomic_fetch_add(p, v, __ATOMIC_RELAXED, __HIP_MEMORY_SCOPE_AGENT); }
__device__ __forceinline__ unsigned xb_xcc_id() { return (unsigned)__builtin_amdgcn_s_getreg((3 << 11) | 20) & 0xFu; }
#define XB_SPIN(cond, bar) do { unsigned _sp = 0; while (cond) { __builtin_amdgcn_s_sleep(1); \
    if ((++_sp & 255u) == 0u) { if (xb_ld(&(bar)[XB_TMO])) break; if (_sp > XB_SPIN_CAP) { atomicAdd(&(bar)[XB_TMO], 1u); break; } } } } while (0)

struct XcdBarrier {
    unsigned* bar; unsigned x;
    volatile LAS unsigned* st;
};

__device__ __forceinline__ XcdBarrier xcd_barrier_post(unsigned* bar, volatile LAS unsigned* st) {
    XcdBarrier b; b.bar = bar; b.x = xb_xcc_id(); b.st = st;
    if (threadIdx.x == 0) (void)xb_add(&bar[XB_XCNT(b.x)], 1u);
    return b;
}
__device__ __forceinline__ void xcd_barrier_complete(unsigned* bar, unsigned x, unsigned& nloc, unsigned& nx) {
    const unsigned G = gridDim.x * gridDim.y * gridDim.z;
    unsigned sum, cnt, mine, sp = 0u;
    for (;;) {
        sum = 0u; cnt = 0u; mine = 0u;
#pragma unroll
        for (unsigned j = 0; j < 16; ++j) { const unsigned c = xb_ld(&bar[XB_XCNT(j)]); sum += c; cnt += (c > 0u) ? 1u : 0u; mine = (j == x) ? c : mine; }
        if (sum == G) break;
        __builtin_amdgcn_s_sleep(1);
        if ((++sp & 255u) == 0u) { if (xb_ld(&bar[XB_TMO])) break; if (sp > XB_SPIN_CAP) { atomicAdd(&bar[XB_TMO], 1u); break; } }
    }
    nloc = mine > 0u ? mine : 1u; nx = cnt > 0u ? cnt : 1u;
}

__device__ __forceinline__ void xcd_barrier(const XcdBarrier& b) {
    asm volatile("s_waitcnt vmcnt(0)" ::: "memory");
    __syncthreads();
    if (threadIdx.x == 0) {
        unsigned* bar = b.bar;
        __builtin_amdgcn_s_waitcnt(0);
        unsigned nloc = b.st[0], nx = b.st[1];
        if (nloc == 0u) { xcd_barrier_complete(bar, b.x, nloc, nx); b.st[0] = nloc; b.st[1] = nx; }
        const unsigned old = xb_add(&bar[XB_XSUB(b.x)], 1u);
        const unsigned gen = old / nloc;
        if (old + 1u == (gen + 1u) * nloc) {
            __builtin_amdgcn_fence(__ATOMIC_RELEASE, "agent");
            asm volatile("s_waitcnt vmcnt(0)" ::: "memory");
            const unsigned og = xb_add(&bar[XB_TOP], 1u);
            const unsigned tg = og / nx;
            if (og + 1u == (tg + 1u) * nx) xb_add(&bar[XB_TOPGEN], 1u);
            else XB_SPIN(xb_ld(&bar[XB_TOPGEN]) == tg, bar);
            __builtin_amdgcn_fence(__ATOMIC_ACQUIRE, "agent");
            xb_add(&bar[XB_XGEN(b.x)], 1u);
            asm volatile("s_waitcnt vmcnt(0)" ::: "memory");
        } else {
            XB_SPIN(xb_ld(&bar[XB_XGEN(b.x)]) == gen, bar);
            __builtin_amdgcn_fence(__ATOMIC_ACQUIRE, "agent");
            asm volatile("s_waitcnt vmcnt(0)" ::: "memory");
        }
    }
    __syncthreads();
}

constexpr int NWAVES = 8, NTHR = 512;
constexpr int DMODEL = 2048, TP = 8192, SEQL = 4096, TSM = 32, DECB = 8, DECS = 4;
constexpr int ATTW = 1024, DIN = 4096, DFF = 5504, PLED = 256, NPAGE = 128, PAGESZ = 128, PASTLEN = 16384;
constexpr float C2F = 0.125f * 1.4426950408889634f, LOG2E = 1.4426950408889634f, NEPS = 1e-6f, SUBLN_EPS = 1e-5f, LAM_INIT = 0.2f;
enum { I_XP = 0, I_XS, I_CK, I_CV, I_SRE, I_SIM, I_SCONV, I_PT, I_PP, I_PS, I_RELB, I_NMIXG, I_WIN, I_LQ1, I_LK1, I_LQ2, I_LK2, I_SUBLNG, I_ARE, I_AIM, I_BRE, I_BIM, I_CRE, I_CIM, I_SD,
       I_LOGDT, I_GLUW, I_GLUB, I_SOUTG, I_WOUT, I_NFFNG, I_WUP, I_CONVW, I_CONVB, I_WDN, I_NPLEG, I_WPG, I_WPP, I_NFING, N_IN };
constexpr size_t O_YP = 0, O_YS = O_YP + (size_t)TP * DMODEL, O_KP = O_YS + (size_t)TSM * DMODEL, O_VP = O_KP + (size_t)TP * ATTW, O_SREP = O_VP + (size_t)TP * ATTW,
                 O_SIMP = O_SREP + 2 * 64 * 64, O_CONVP = O_SIMP + 2 * 64 * 64, O_KS = O_CONVP + 2 * 2 * DFF, O_VS = O_KS + (size_t)TSM * ATTW, O_SRES = O_VS + (size_t)TSM * ATTW,
                 O_SIMS = O_SRES + 8 * 64 * 64, O_CONVS = O_SIMS + 8 * 64 * 64, O_END = O_CONVS + 8 * 2 * DFF;
constexpr size_t al256(size_t x) { return (x + 255) & ~(size_t)255; }
constexpr size_t WS_CTL = 0, CTL_ZERO_BYTES = 1u << 20;
constexpr int CW_BAR = 4096;
constexpr size_t WS_WIN = CTL_ZERO_BYTES;
constexpr size_t WS_WOUT = WS_WIN + (size_t)DIN * DMODEL * 2;
constexpr size_t WS_WUP = WS_WOUT + (size_t)DMODEL * DMODEL * 2;
constexpr size_t WS_WDN = WS_WUP + (size_t)2 * DFF * DMODEL * 2;
constexpr size_t WS_WPG = WS_WDN + (size_t)DMODEL * DFF * 2;
constexpr size_t WS_WPP = WS_WPG + (size_t)DMODEL * DMODEL * 2;
constexpr size_t WS_XB = WS_WPP + (size_t)DMODEL * PLED * 2;
constexpr size_t WS_RSX = WS_XB + (size_t)TP * DMODEL * 2;
constexpr size_t WS_PB = WS_RSX + al256((TP + TSM) * 4);
constexpr size_t WS_QB = WS_PB + (size_t)TP * PLED * 2;
constexpr size_t WS_KB = WS_QB + (size_t)TP * ATTW * 2;
constexpr size_t WS_VB = WS_KB + (size_t)TP * ATTW * 2;
constexpr size_t WS_US = WS_VB + (size_t)TP * ATTW * 2;
constexpr size_t WS_O1 = WS_US + (size_t)TP * ATTW * 4;
constexpr size_t WS_O2 = WS_O1 + (size_t)TP * ATTW * 2;
constexpr size_t WS_GS = WS_O2 + (size_t)TP * ATTW * 2;
constexpr size_t WS_OA = WS_GS + (size_t)TP * ATTW * 2;
constexpr size_t WS_H1 = WS_OA + (size_t)TP * DMODEL * 2;
constexpr size_t WS_H1B = WS_H1 + (size_t)TP * DMODEL * 4;
constexpr size_t WS_SS1 = WS_H1B + (size_t)TP * DMODEL * 2;
constexpr size_t WS_G = WS_SS1 + (size_t)TP * 8 * 4;
constexpr size_t WS_V2 = WS_G + (size_t)TP * DFF * 2;
constexpr size_t WS_HFF = WS_V2 + (size_t)TP * DFF * 2;
constexpr size_t WS_H2 = WS_HFF + (size_t)TP * DFF * 2;
constexpr size_t WS_H2B = WS_H2 + (size_t)TP * DMODEL * 4;
constexpr size_t WS_SS2 = WS_H2B + (size_t)TP * DMODEL * 2;
constexpr size_t WS_PROJ = WS_SS2 + (size_t)TP * 8 * 4;
constexpr size_t WS_SS3 = WS_PROJ + (size_t)TP * DMODEL * 2;
constexpr size_t WS_AB = WS_SS3 + (size_t)TP * 8 * 4;
constexpr size_t WS_BBR = WS_AB + 64 * 64 * 2 * 4;
constexpr size_t WS_BBI = WS_BBR + 64 * 64 * 16 * 4;
constexpr size_t WS_LUT = WS_BBI + 64 * 64 * 16 * 4;
constexpr size_t WS_LAM = WS_LUT + al256(8 * 130 * 4);
constexpr size_t WS_XSB = WS_LAM + 256;
constexpr size_t WS_PSB = WS_XSB + (size_t)TSM * DMODEL * 2;
constexpr size_t WS_QS = WS_PSB + (size_t)TSM * PLED * 2;
constexpr size_t WS_USS = WS_QS + (size_t)TSM * ATTW * 4;
constexpr size_t WS_PROJS = WS_USS + (size_t)TSM * ATTW * 4;
constexpr size_t WS_GSS = WS_PROJS + (size_t)TSM * DMODEL * 4;
constexpr size_t WS_OAS = WS_GSS + (size_t)TSM * ATTW * 2;
constexpr size_t WS_H1S = WS_OAS + (size_t)TSM * DMODEL * 2;
constexpr size_t WS_H1SB = WS_H1S + (size_t)TSM * DMODEL * 4;
constexpr size_t WS_SS1S = WS_H1SB + (size_t)TSM * DMODEL * 2;
constexpr size_t WS_GUS = WS_SS1S + (size_t)TSM * 128 * 4;
constexpr size_t WS_VUS = WS_GUS + al256((size_t)TSM * DFF * 4);
constexpr size_t WS_HFFS = WS_VUS + al256((size_t)TSM * DFF * 4);
constexpr size_t WS_H2S = WS_HFFS + al256((size_t)TSM * DFF * 2);
constexpr size_t WS_H2SB = WS_H2S + (size_t)TSM * DMODEL * 4;
constexpr size_t WS_SS2S = WS_H2SB + (size_t)TSM * DMODEL * 2;
constexpr size_t WS_SS3S = WS_SS2S + (size_t)TSM * 128 * 4;
constexpr size_t WS_PART = WS_SS3S + (size_t)TSM * 128 * 4;
constexpr size_t WS_END = WS_PART + al256((size_t)256 * 8 * 130 * 4);
constexpr int RING_OFF = 0, RING_BYTES = 131072;
constexpr int LDSCTL_OFF = RING_BYTES, MISC_OFF = LDSCTL_OFF + 320;
constexpr int LUT_OFF = RING_BYTES + 1024;
constexpr int RS_OFF = LUT_OFF + 4352;
constexpr int LUTX_OFF = 90112;
constexpr int LDS_BYTES = 147456;
static_assert(RS_OFF + 256 <= LDS_BYTES, "LDS map");

struct Args { const float* in[N_IN]; float* out; unsigned char* ws; };

__device__ __forceinline__ float wave_sum(float v) {
#pragma unroll
    for (int o = 1; o < 64; o <<= 1) v += __shfl_xor(v, o);
    return v;
}
__device__ __forceinline__ float bflo(unsigned w) { return __uint_as_float(w << 16); }
__device__ __forceinline__ float bfhi(unsigned w) { return __uint_as_float(w & 0xffff0000u); }
__device__ __forceinline__ float sigmoidf_(float x) { return __builtin_amdgcn_rcpf(1.f + __builtin_amdgcn_exp2f(-LOG2E * x)); }
__device__ __forceinline__ float gelu_tanh(float x) { const float z = 0.7978845608028654f * (x + 0.044715f * x * x * x); return x * __builtin_amdgcn_rcpf(1.f + __builtin_amdgcn_exp2f(-2.f * LOG2E * z)); }
#define MFMA_SETTLE(x) asm volatile("s_nop 15\n\ts_nop 15" : "+v"(x))
#define WG_SYNC() do { asm volatile("s_waitcnt vmcnt(0) lgkmcnt(0)" ::: "memory"); __builtin_amdgcn_s_barrier(); asm volatile("" ::: "memory"); } while (0)

__device__ __forceinline__ void p0_transpose_item(const float* W, int K, int N, const float* gain, bf16* WT, int upmode, LAS float* scr, int item, int lane) {
    const int nblk = N / 32, kb = item / nblk, nb = item % nblk, k0 = 64 * kb, n0 = 32 * nb;
#pragma unroll 8
    for (int i = 0; i < 32; ++i) { const int kk = 2 * i + (lane >> 5); const float g = gain ? gain[k0 + kk] : 1.f; scr[kk * 33 + (lane & 31)] = W[(size_t)(k0 + kk) * N + n0 + (lane & 31)] * g; }
    LDS_WAIT(); asm volatile("" ::: "memory");
    int drow0 = n0;
    if (upmode) { const int isv = n0 >= DFF, j = isv ? n0 - DFF : n0; drow0 = 256 * (j >> 7) + (isv ? 128 : 0) + (j & 127); }
    const int c = lane & 7;
#pragma unroll
    for (int j = 0; j < 4; ++j) { const int n = (lane >> 3) + 8 * j; const LAS float* s = scr + (8 * c) * 33 + n;
        v4u o; o.x = pk2(s[0 * 33], s[1 * 33]); o.y = pk2(s[2 * 33], s[3 * 33]); o.z = pk2(s[4 * 33], s[5 * 33]); o.w = pk2(s[6 * 33], s[7 * 33]);
        *(GAS v4u*)(WT + (size_t)(drow0 + n) * K + k0 + 8 * c) = o; }
    LDS_WAIT(); asm volatile("" ::: "memory");
}
__device__ __forceinline__ void p0_row2048(const float* xrow, bf16* orow, float* rstd_out, int lane) {
    const GAS f32x4* xr = (const GAS f32x4*)xrow + lane; f32x4 v[8]; float s = 0.f;
#pragma unroll
    for (int j = 0; j < 8; ++j) { v[j] = xr[64 * j]; s += (v[j].x * v[j].x + v[j].y * v[j].y) + (v[j].z * v[j].z + v[j].w * v[j].w); }
    s = wave_sum(s);
    if (lane == 0) *rstd_out = 1.0f / sqrtf(s * (1.0f / 2048.0f) + NEPS);
    GAS unsigned long long* o8 = (GAS unsigned long long*)orow + lane;
#pragma unroll
    for (int j = 0; j < 8; ++j) o8[64 * j] = (unsigned long long)pk2(v[j].x, v[j].y) | ((unsigned long long)pk2(v[j].z, v[j].w) << 32);
}
__device__ __forceinline__ int t5_bucket(int n) {
    if (n < 16) return n;
    int b = 16 + (int)(logf((float)n / 16.0f) / 2.0794415416798357f * 16.0f);
    return b > 31 ? 31 : b;
}
__device__ __forceinline__ void p0_prologue(const Args& A, LAS unsigned char* lds, int vcu, int G, int wave, int lane) {
    unsigned char* ws = A.ws;
    LAS float* scr = (LAS float*)(lds + RING_OFF + wave * 16384);
    const int gw = vcu * NWAVES + wave, NGW = G * NWAVES;
    constexpr int I_IN = (DMODEL / 64) * (DIN / 32), I_OUT = (DMODEL / 64) * (DMODEL / 32), I_UP = (DMODEL / 64) * (2 * DFF / 32), I_DN = (DFF / 64) * (DMODEL / 32), I_PG = I_OUT, I_PPJ = (PLED / 64) * (DMODEL / 32);
    constexpr int NITEMS = I_IN + I_OUT + I_UP + I_DN + I_PG + I_PPJ;
    for (int it = gw; it < NITEMS; it += NGW) {
        int r = it;
        if (r < I_IN) { p0_transpose_item(A.in[I_WIN], DMODEL, DIN, A.in[I_NMIXG], (bf16*)(ws + WS_WIN), 0, scr, r, lane); continue; } r -= I_IN;
        if (r < I_OUT) { p0_transpose_item(A.in[I_WOUT], DMODEL, DMODEL, nullptr, (bf16*)(ws + WS_WOUT), 0, scr, r, lane); continue; } r -= I_OUT;
        if (r < I_UP) { p0_transpose_item(A.in[I_WUP], DMODEL, 2 * DFF, A.in[I_NFFNG], (bf16*)(ws + WS_WUP), 1, scr, r, lane); continue; } r -= I_UP;
        if (r < I_DN) { p0_transpose_item(A.in[I_WDN], DFF, DMODEL, nullptr, (bf16*)(ws + WS_WDN), 0, scr, r, lane); continue; } r -= I_DN;
        if (r < I_PG) { p0_transpose_item(A.in[I_WPG], DMODEL, DMODEL, A.in[I_NPLEG], (bf16*)(ws + WS_WPG), 0, scr, r, lane); continue; } r -= I_PG;
        p0_transpose_item(A.in[I_WPP], PLED, DMODEL, nullptr, (bf16*)(ws + WS_WPP), 0, scr, r, lane);
    }
    for (int m = gw; m < TP + TSM; m += NGW) {
        if (m < TP) p0_row2048(A.in[I_XP] + (size_t)m * DMODEL, (bf16*)(ws + WS_XB) + (size_t)m * DMODEL, (float*)(ws + WS_RSX) + m, lane);
        else p0_row2048(A.in[I_XS] + (size_t)(m - TP) * DMODEL, (bf16*)(ws + WS_XSB) + (size_t)(m - TP) * DMODEL, (float*)(ws + WS_RSX) + m, lane);
    }
    for (int m = gw; m < TP + TSM; m += NGW) {
        const float* src = m < TP ? A.in[I_PP] + (size_t)m * PLED : A.in[I_PS] + (size_t)(m - TP) * PLED;
        bf16* dst = m < TP ? (bf16*)(ws + WS_PB) + (size_t)m * PLED : (bf16*)(ws + WS_PSB) + (size_t)(m - TP) * PLED;
        const f32x4 v = ((const GAS f32x4*)src)[lane];
        ((GAS unsigned long long*)dst)[lane] = (unsigned long long)pk2(v.x, v.y) | ((unsigned long long)pk2(v.z, v.w) << 32);
    }
    const int gt = gw * 64 + lane;
    if (gt < 64 * 64) {
        const int g = gt >> 6;
        const float dt = expf(A.in[I_LOGDT][g]), are = A.in[I_ARE][gt], aim = A.in[I_AIM][gt];
        const float decay = expf(are * dt), abr = decay * cosf(aim * dt), abi = decay * sinf(aim * dt);
        const float den = are * are + aim * aim, numr = abr - 1.0f;
        const float cr = (numr * are + abi * aim) / den, ci = (abi * are - numr * aim) / den;
        float* AB = (float*)(ws + WS_AB); AB[gt * 2] = abr; AB[gt * 2 + 1] = abi;
        float* BBR = (float*)(ws + WS_BBR); float* BBI = (float*)(ws + WS_BBI);
        for (int c = 0; c < 16; ++c) { const float br = A.in[I_BRE][gt * 16 + c], bi = A.in[I_BIM][gt * 16 + c]; BBR[gt * 16 + c] = cr * br - ci * bi; BBI[gt * 16 + c] = cr * bi + ci * br; }
    }
    if (gt >= 4096 && gt < 4096 + 8 * 130) {
        const int q = gt - 4096, h = q / 130, idx = q % 130; const float* tb = A.in[I_RELB]; const float far = tb[31 * 8 + h];
        float v;
        if (idx == 0) v = -INFINITY; else if (idx == 129) v = 0.f; else v = (tb[t5_bucket(idx - 1) * 8 + h] - far) * LOG2E;
        ((float*)(ws + WS_LUT))[q] = v;
    }
    if (gt == 8192) {
        float s1 = 0.f, s2 = 0.f;
        for (int i = 0; i < 64; ++i) { s1 += A.in[I_LQ1][i] * A.in[I_LK1][i]; s2 += A.in[I_LQ2][i] * A.in[I_LK2][i]; }
        *(float*)(ws + WS_LAM) = expf(s1) - expf(s2) + LAM_INIT;
    }
}

template <class F> __device__ __forceinline__ void small_gemm(LAS unsigned char* lds, const bf16* A, const bf16* Bt, int N, int K, int cu, int ncu, float* ssout, F&& epi) {
    int tid_o = threadIdx.x; asm volatile("" : "+v"(tid_o));
    const int tid = tid_o, lane = tid & 63, wid = __builtin_amdgcn_readfirstlane(tid >> 6), i = lane & 15, kq = lane >> 4;
    const int nk = K / 32, ks0 = (wid * nk) / 8, ks1 = ((wid + 1) * nk) / 8, nslab = N / 16;
    LAS float* part = (LAS float*)lds;
    for (int slab = cu; slab < nslab; slab += ncu) {
        f32x4 acc0 = {0.f, 0.f, 0.f, 0.f}, acc1 = {0.f, 0.f, 0.f, 0.f};
        const bf16* bp = Bt + (size_t)(slab * 16 + i) * K + kq * 8;
        const bf16* ap0 = A + (size_t)i * K + kq * 8; const bf16* ap1 = ap0 + (size_t)16 * K;
#pragma unroll 4
        for (int ks = ks0; ks < ks1; ++ks) {
            const bf16x8 b = *(const bf16x8*)(bp + ks * 32), a0 = *(const bf16x8*)(ap0 + ks * 32), a1 = *(const bf16x8*)(ap1 + ks * 32);
            acc0 = __builtin_amdgcn_mfma_f32_16x16x32_bf16(a0, b, acc0, 0, 0, 0);
            acc1 = __builtin_amdgcn_mfma_f32_16x16x32_bf16(a1, b, acc1, 0, 0, 0);
        }
        asm volatile("s_nop 15\n\ts_nop 15" : "+v"(acc0), "+v"(acc1));
#pragma unroll
        for (int r = 0; r < 4; ++r) { part[wid * 512 + (4 * kq + r) * 16 + i] = acc0[r]; part[wid * 512 + (16 + 4 * kq + r) * 16 + i] = acc1[r]; }
        WG_SYNC();
        float v = 0.f;
#pragma unroll
        for (int w = 0; w < 8; ++w) v += part[w * 512 + tid];
        const float h = epi(tid >> 4, slab * 16 + (tid & 15), v);
        if (ssout) { float q = h * h; q += __shfl_xor(q, 1); q += __shfl_xor(q, 2); q += __shfl_xor(q, 4); q += __shfl_xor(q, 8); if ((tid & 15) == 0) ssout[(tid >> 4) * nslab + slab] = q; }
        WG_SYNC();
    }
}
__device__ __forceinline__ void sample_rstd_table(LAS unsigned char* lds, const float* ss) {
    int tid_o = threadIdx.x; asm volatile("" : "+v"(tid_o));
    const int tid = tid_o, row = tid >> 4, j = tid & 15;
    float q = 0.f;
#pragma unroll
    for (int e = 0; e < 8; ++e) q += ss[row * 128 + j * 8 + e];
    q += __shfl_xor(q, 1); q += __shfl_xor(q, 2); q += __shfl_xor(q, 4); q += __shfl_xor(q, 8);
    if (j == 0) ((LAS float*)(lds + RS_OFF))[row] = 1.0f / sqrtf(q * (1.0f / 2048.0f) + NEPS);
    WG_SYNC();
}
template <int CTRL> __device__ __forceinline__ float dppf(float x) { return __builtin_bit_cast(float, __builtin_amdgcn_update_dpp(0, __builtin_bit_cast(int, x), CTRL, 0xf, 0xf, true)); }
__device__ __forceinline__ float dot4(f32x4 a, f32x4 b) { return (a.x * b.x + a.y * b.y) + (a.z * b.z + a.w * b.w); }
struct KV4 { f32x4 k0, k1, v0, v1; };
typedef __bf16 bf16x2_t __attribute__((ext_vector_type(2)));
__device__ __forceinline__ float dot2bf(unsigned k, unsigned q, float acc) { return __builtin_amdgcn_fdot2_f32_bf16(__builtin_bit_cast(bf16x2_t, k), __builtin_bit_cast(bf16x2_t, q), acc, false); }
__device__ __forceinline__ unsigned cvtpk_u(float lo, float hi) { typedef float f32x2_t __attribute__((ext_vector_type(2))); f32x2_t v = {lo, hi}; return __builtin_bit_cast(unsigned, __builtin_convertvector(v, bf16x2_t)); }
__device__ __forceinline__ void decode_unit(const Args& A, int unit, LAS unsigned char* lds, int wid, int lane) {
    unsigned char* ws = A.ws;
    const int bh = unit >> 2, split = unit & 3, b = bh >> 3, h = bh & 7, r = lane >> 4, c = lane & 15;
    const float* QS = (const float*)(ws + WS_QS);
    unsigned qp[4][4];
#pragma unroll
    for (int i = 0; i < 4; ++i) { const float* qp_ = QS + (size_t)(b * 4 + i) * 1024 + h * 128 + 8 * c; const f32x4 a = *(const f32x4*)qp_, bq = *(const f32x4*)(qp_ + 4);
        qp[i][0] = pk2(a.x, a.y); qp[i][1] = pk2(a.z, a.w); qp[i][2] = pk2(bq.x, bq.y); qp[i][3] = pk2(bq.z, bq.w); }
    float m[4], l[4]; f32x4 acc[4][2][2];
#pragma unroll
    for (int i = 0; i < 4; ++i) { m[i] = -INFINITY; l[i] = 0.f;
#pragma unroll
        for (int e = 0; e < 2; ++e) { acc[i][e][0] = (f32x4){0.f, 0.f, 0.f, 0.f}; acc[i][e][1] = (f32x4){0.f, 0.f, 0.f, 0.f}; } }
    const int* pt = (const int*)A.in[I_PT] + b * NPAGE + split * 32 + wid;
    const int ph0 = pt[0], ph1 = pt[8], ph2 = pt[16], ph3 = pt[24];
    const float* CK = A.in[I_CK]; const float* CV = A.in[I_CV];
    const LAS float* lut = (const LAS float*)(lds + LUT_OFF) + h * 130;
#define DEC_LOAD(buf, it_) do { const int itc_ = (it_) < 127 ? (it_) : 127; const int pg_ = itc_ >> 5; const int ph_ = pg_ == 0 ? ph0 : (pg_ == 1 ? ph1 : (pg_ == 2 ? ph2 : ph3)); \
        const size_t off_ = ((size_t)ph_ * PAGESZ + (size_t)(((itc_ & 31) << 2) + r)) * 1024 + h * 128 + 8 * c; \
        buf.k0 = __builtin_nontemporal_load((const f32x4*)(CK + off_)); buf.k1 = __builtin_nontemporal_load((const f32x4*)(CK + off_ + 4)); \
        buf.v0 = __builtin_nontemporal_load((const f32x4*)(CV + off_)); buf.v1 = __builtin_nontemporal_load((const f32x4*)(CV + off_ + 4)); } while (0)
#define DEC_COMPUTE(buf, it_) do { float s[4]; \
        const unsigned kp0_ = cvtpk_u(buf.k0.x, buf.k0.y), kp1_ = cvtpk_u(buf.k0.z, buf.k0.w), kp2_ = cvtpk_u(buf.k1.x, buf.k1.y), kp3_ = cvtpk_u(buf.k1.z, buf.k1.w); \
        _Pragma("unroll") for (int i = 0; i < 4; ++i) { float p_ = dot2bf(kp0_, qp[i][0], 0.f); p_ = dot2bf(kp1_, qp[i][1], p_); p_ = dot2bf(kp2_, qp[i][2], p_); p_ = dot2bf(kp3_, qp[i][3], p_); \
            p_ += dppf<0xB1>(p_); p_ += dppf<0x4E>(p_); p_ += dppf<0x141>(p_); s[i] = p_; } \
        const int page_ = split * 32 + wid + 8 * ((it_) >> 5); \
        if (page_ == NPAGE - 1) { const int kpos_ = page_ * PAGESZ + (((it_) & 31) << 2) + r; \
            _Pragma("unroll") for (int i = 0; i < 4; ++i) { int d_ = PASTLEN + i - kpos_ + 1; d_ = d_ > 129 ? 129 : d_; s[i] += lut[d_]; } } \
        bool need_ = false; \
        _Pragma("unroll") for (int i = 0; i < 4; ++i) need_ |= s[i] > m[i]; \
        if (__any(need_)) { \
            _Pragma("unroll") for (int i = 0; i < 4; ++i) { const float mn_ = fmaxf(m[i], s[i]); const float a_ = __builtin_amdgcn_exp2f(m[i] - mn_); m[i] = mn_; l[i] *= a_; const float ao_ = dppf<0x128>(a_); \
                acc[i][0][0] = acc[i][0][0] * a_; acc[i][0][1] = acc[i][0][1] * a_; acc[i][1][0] = acc[i][1][0] * ao_; acc[i][1][1] = acc[i][1][1] * ao_; } } \
        _Pragma("unroll") for (int i = 0; i < 4; ++i) { const float p_ = __builtin_amdgcn_exp2f(s[i] - m[i]); l[i] += p_; const float po_ = dppf<0x128>(p_); \
            acc[i][0][0] = acc[i][0][0] + buf.v0 * p_; acc[i][0][1] = acc[i][0][1] + buf.v1 * p_; acc[i][1][0] = acc[i][1][0] + buf.v0 * po_; acc[i][1][1] = acc[i][1][1] + buf.v1 * po_; } \
    } while (0)
    KV4 bA, bB, bC;
    DEC_LOAD(bA, 0); DEC_LOAD(bB, 1);
#pragma unroll 1
    for (int it = 0; it < 126; it += 3) {
        DEC_LOAD(bC, it + 2); DEC_COMPUTE(bA, it); __builtin_amdgcn_sched_barrier(0);
        DEC_LOAD(bA, it + 3); DEC_COMPUTE(bB, it + 1); __builtin_amdgcn_sched_barrier(0);
        DEC_LOAD(bB, it + 4); DEC_COMPUTE(bC, it + 2); __builtin_amdgcn_sched_barrier(0);
    }
    DEC_COMPUTE(bA, 126); __builtin_amdgcn_sched_barrier(0); DEC_COMPUTE(bB, 127); __builtin_amdgcn_sched_barrier(0);
#undef DEC_LOAD
#undef DEC_COMPUTE
    int lane2 = lane; asm volatile("" : "+v"(lane2));
    const int r2 = lane2 >> 4, c2 = lane2 & 15;
    float m2[4][2], l2[4][2];
#pragma unroll
    for (int i = 0; i < 4; ++i) { m2[i][0] = m[i]; l2[i][0] = l[i]; m2[i][1] = __shfl_xor(m[i], 8); l2[i][1] = __shfl_xor(l[i], 8); }
#pragma unroll
    for (int sh = 16; sh <= 32; sh <<= 1)
#pragma unroll
        for (int i = 0; i < 4; ++i)
#pragma unroll
            for (int e = 0; e < 2; ++e) {
                const float mo = __shfl_xor(m2[i][e], sh), lo = __shfl_xor(l2[i][e], sh), mn = fmaxf(m2[i][e], mo);
                const float a = (m2[i][e] == -INFINITY) ? 0.f : __builtin_amdgcn_exp2f(m2[i][e] - mn), ao = (mo == -INFINITY) ? 0.f : __builtin_amdgcn_exp2f(mo - mn);
                l2[i][e] = l2[i][e] * a + lo * ao; m2[i][e] = mn;
#pragma unroll
                for (int hh = 0; hh < 2; ++hh)
#pragma unroll
                    for (int x = 0; x < 4; ++x) { const float vo = __shfl_xor(acc[i][e][hh][x], sh); acc[i][e][hh][x] = acc[i][e][hh][x] * a + vo * ao; }
            }
    LAS float* WM = (LAS float*)lds;
    if (r2 == 0) {
#pragma unroll
        for (int i = 0; i < 4; ++i)
#pragma unroll
            for (int e = 0; e < 2; ++e) { const int mp = (c2 >> 3) ^ e; LAS float* dst = WM + (size_t)(wid * 8 + i * 2 + mp) * 130;
                *(LAS f32x4*)(dst + 2 + 8 * c2) = acc[i][e][0]; *(LAS f32x4*)(dst + 2 + 8 * c2 + 4) = acc[i][e][1];
                if ((c2 & 7) == 0) { dst[0] = m2[i][e]; dst[1] = l2[i][e]; } }
    }
    WG_SYNC();
    {
        const int tid = wid * 64 + lane2, imp = tid >> 6, e2 = (tid & 63) * 2;
        float mm = -INFINITY;
#pragma unroll
        for (int w = 0; w < 8; ++w) mm = fmaxf(mm, WM[(w * 8 + imp) * 130]);
        float ll = 0.f, a0 = 0.f, a1 = 0.f;
#pragma unroll
        for (int w = 0; w < 8; ++w) { const LAS float* src = WM + (w * 8 + imp) * 130; const float mw = src[0]; const float f = (mw == -INFINITY) ? 0.f : __builtin_amdgcn_exp2f(mw - mm);
            ll += src[1] * f; a0 += src[2 + e2] * f; a1 += src[3 + e2] * f; }
        float* dst = (float*)(ws + WS_PART) + (size_t)(unit * 8 + imp) * 130;
        dst[2 + e2] = a0; dst[3 + e2] = a1; if ((tid & 63) == 0) { dst[0] = mm; dst[1] = ll; }
    }
    WG_SYNC();
}

struct SsmConst { float abr, abi, dsk, glub; bf16x8 b1[4][2]; bf16x8 c2[4]; bf16x8 w3; };
constexpr int SSM_WL = 15872, SSM_HS = 10240, SSM_GS = 10240 + 4352, SSM_EX = 126976;
__device__ __forceinline__ bf16x8 pack_bf8(float a0, float a1, float a2, float a3, float a4, float a5, float a6, float a7) {
    v4u w; w.x = pk2(a0, a1); w.y = pk2(a2, a3); w.z = pk2(a4, a5); w.w = pk2(a6, a7); return __builtin_bit_cast(bf16x8, w);
}
__device__ __forceinline__ void ssm_build_const(const Args& A, int g, int lane, SsmConst& C) {
    unsigned char* ws = A.ws; const int i = lane & 15, kq = lane >> 4;
    const float* AB = (const float*)(ws + WS_AB); C.abr = AB[(g * 64 + lane) * 2]; C.abi = AB[(g * 64 + lane) * 2 + 1];
    C.dsk = A.in[I_SD][g * 16 + i]; C.glub = A.in[I_GLUB][g * 16 + i];
    const bf16x8 zero = {0, 0, 0, 0, 0, 0, 0, 0};
#pragma unroll
    for (int sb = 0; sb < 4; ++sb)
#pragma unroll
        for (int part = 0; part < 2; ++part) {
            C.b1[sb][part] = zero;
            if (kq < 2) { const float* p = (const float*)(ws + (part ? WS_BBI : WS_BBR)) + (size_t)(g * 64 + 16 * sb + i) * 16 + 8 * kq; C.b1[sb][part] = pack_bf8(p[0], p[1], p[2], p[3], p[4], p[5], p[6], p[7]); }
        }
    const float* cre = A.in[I_CRE] + (size_t)(g * 16 + i) * 64; const float* cim = A.in[I_CIM] + (size_t)(g * 16 + i) * 64;
#pragma unroll
    for (int s = 0; s < 4; ++s) { const int n0 = 16 * s + 4 * kq; C.c2[s] = pack_bf8(cre[n0], -cim[n0], cre[n0 + 1], -cim[n0 + 1], cre[n0 + 2], -cim[n0 + 2], cre[n0 + 3], -cim[n0 + 3]); }
    C.w3 = zero;
    if (kq < 2) { const float* w = A.in[I_GLUW] + (size_t)(g * 16 + 8 * kq) * 16 + i; C.w3 = pack_bf8(w[0], w[16], w[32], w[48], w[64], w[80], w[96], w[112]); }
}
template <bool FULL> __device__ __forceinline__ void ssm_tile(const SsmConst& C, const float* us, int ntok, bf16* gs, float& hr, float& hi, LAS unsigned char* wl, int lane) {
    const int i = lane & 15, kq = lane >> 4;
    const bf16x8 zero = {0, 0, 0, 0, 0, 0, 0, 0}; const f32x4 fz = {0.f, 0.f, 0.f, 0.f};
    bf16x8 a1 = zero;
    if (kq < 2 && i < ntok) { const float* p = us + (size_t)i * 1024 + 8 * kq; const f32x4 x0 = *(const f32x4*)p, x1 = *(const f32x4*)(p + 4); a1 = pack_bf8(x0.x, x0.y, x0.z, x0.w, x1.x, x1.y, x1.z, x1.w); }
    LAS float* BUs = (LAS float*)wl;
    { f32x4 dd[4][2];
#pragma unroll
    for (int sb = 0; sb < 4; ++sb)
#pragma unroll
        for (int part = 0; part < 2; ++part) dd[sb][part] = __builtin_amdgcn_mfma_f32_16x16x32_bf16(a1, C.b1[sb][part], fz, 0, 0, 0);
    asm volatile("s_nop 15\n\ts_nop 15" : "+v"(dd[0][0]), "+v"(dd[0][1]), "+v"(dd[1][0]), "+v"(dd[1][1]), "+v"(dd[2][0]), "+v"(dd[2][1]), "+v"(dd[3][0]), "+v"(dd[3][1]));
#pragma unroll
    for (int sb = 0; sb < 4; ++sb)
#pragma unroll
        for (int part = 0; part < 2; ++part) *(LAS f32x4*)(BUs + (part * 64 + 16 * sb + i) * 20 + 4 * kq) = dd[sb][part]; }
    f32x4 br[4], bi[4];
#pragma unroll
    for (int qd = 0; qd < 4; ++qd) { br[qd] = *(const LAS f32x4*)(BUs + lane * 20 + 4 * qd); bi[qd] = *(const LAS f32x4*)(BUs + (64 + lane) * 20 + 4 * qd); }
    LAS unsigned* Hs = (LAS unsigned*)(wl + SSM_HS);
#pragma unroll
    for (int t = 0; t < 16; ++t) {
        if (t < ntok) { const float bur = br[t >> 2][t & 3], bui = bi[t >> 2][t & 3];
            const float nr = C.abr * hr - C.abi * hi + bur, ni = C.abr * hi + C.abi * hr + bui; hr = nr; hi = ni;
            if (FULL) Hs[t * 68 + lane] = pk2(hr, hi); }
    }
    if (FULL) {
        f32x4 y = fz;
#pragma unroll
        for (int s = 0; s < 4; ++s) { const bf16x8 a2 = *(const LAS bf16x8*)((LAS unsigned char*)Hs + i * 272 + (32 * s + 8 * kq) * 2); y = __builtin_amdgcn_mfma_f32_16x16x32_bf16(a2, C.c2[s], y, 0, 0, 0); }
        MFMA_SETTLE(y);
        float gg[4];
        LAS unsigned short* Gs = (LAS unsigned short*)(wl + SSM_GS);
#pragma unroll
        for (int r = 0; r < 4; ++r) { const int tok = 4 * kq + r; float u = 0.f; if (tok < ntok) u = us[(size_t)tok * 1024 + i]; gg[r] = gelu_tanh(y[r] + C.dsk * u); Gs[tok * 24 + i] = (unsigned short)f2bf(gg[r]); }
        bf16x8 a3 = zero;
        if (kq < 2) a3 = *(const LAS bf16x8*)(Gs + i * 24 + 8 * kq);
        f32x4 gp = __builtin_amdgcn_mfma_f32_16x16x32_bf16(a3, C.w3, fz, 0, 0, 0);
        MFMA_SETTLE(gp);
#pragma unroll
        for (int r = 0; r < 4; ++r) { const int tok = 4 * kq + r; if (tok < ntok) gs[(size_t)tok * 1024 + i] = (bf16)f2bf(gg[r] * sigmoidf_(gp[r] + C.glub)); }
    }
}
__device__ __forceinline__ void ssm_prompt_unit(const Args& A, int b, int g, LAS unsigned char* lds, int wid, int lane) {
    unsigned char* ws = A.ws; LAS unsigned char* wl = lds + wid * SSM_WL;
    SsmConst C; ssm_build_const(A, g, lane, C);
    const size_t row0 = (size_t)b * SEQL + wid * 512;
    const float* us = (const float*)(ws + WS_US) + row0 * 1024 + g * 16; bf16* gs = (bf16*)(ws + WS_GS) + row0 * 1024 + g * 16;
    float hr = 0.f, hi = 0.f;
    for (int tile = 0; tile < 32; ++tile) ssm_tile<false>(C, us + (size_t)tile * 16 * 1024, 16, nullptr, hr, hi, wl, lane);
    LAS float* EX = (LAS float*)(lds + SSM_EX);
    EX[(wid * 64 + lane) * 2] = hr; EX[(wid * 64 + lane) * 2 + 1] = hi;
    WG_SYNC();
    float pr = C.abr, pi = C.abi;
#pragma unroll
    for (int k = 0; k < 9; ++k) { const float nr = pr * pr - pi * pi, ni = 2.f * pr * pi; pr = nr; pi = ni; }
    float sr = 0.f, si = 0.f;
    for (int w = 0; w < wid; ++w) { const float er = EX[(w * 64 + lane) * 2], ei = EX[(w * 64 + lane) * 2 + 1]; const float nr = pr * sr - pi * si + er, ni = pr * si + pi * sr + ei; sr = nr; si = ni; }
    hr = sr; hi = si;
    for (int tile = 0; tile < 32; ++tile) ssm_tile<true>(C, us + (size_t)tile * 16 * 1024, 16, gs + (size_t)tile * 16 * 1024, hr, hi, wl, lane);
    if (wid == 7) { A.out[O_SREP + (size_t)(b * 64 + g) * 64 + lane] = hr; A.out[O_SIMP + (size_t)(b * 64 + g) * 64 + lane] = hi; }
    WG_SYNC();
}
__device__ __forceinline__ void ssm_sample_wave(const Args& A, int bs, int g, LAS unsigned char* lds, int wid, int lane) {
    unsigned char* ws = A.ws; LAS unsigned char* wl = lds + wid * SSM_WL;
    SsmConst C; ssm_build_const(A, g, lane, C);
    const size_t si_ = (size_t)(bs * 64 + g) * 64 + lane;
    float hr = A.in[I_SRE][si_], hi = A.in[I_SIM][si_];
    ssm_tile<true>(C, (const float*)(ws + WS_USS) + (size_t)bs * 4 * 1024 + g * 16, 4, (bf16*)(ws + WS_GSS) + (size_t)bs * 4 * 1024 + g * 16, hr, hi, wl, lane);
    A.out[O_SRES + si_] = hr; A.out[O_SIMS + si_] = hi;
}

__device__ __forceinline__ void unpack16(const bf16* p, float (&v)[16]) {
    const v4u a = *(const GAS v4u*)p, b = *(const GAS v4u*)(p + 8);
    v[0] = bflo(a.x); v[1] = bfhi(a.x); v[2] = bflo(a.y); v[3] = bfhi(a.y); v[4] = bflo(a.z); v[5] = bfhi(a.z); v[6] = bflo(a.w); v[7] = bfhi(a.w);
    v[8] = bflo(b.x); v[9] = bfhi(b.x); v[10] = bflo(b.y); v[11] = bfhi(b.y); v[12] = bflo(b.z); v[13] = bfhi(b.z); v[14] = bflo(b.w); v[15] = bfhi(b.w);
}
__device__ __forceinline__ void store16(bf16* p, const float (&v)[16]) {
    v4u a, b; a.x = pk2(v[0], v[1]); a.y = pk2(v[2], v[3]); a.z = pk2(v[4], v[5]); a.w = pk2(v[6], v[7]); b.x = pk2(v[8], v[9]); b.y = pk2(v[10], v[11]); b.z = pk2(v[12], v[13]); b.w = pk2(v[14], v[15]);
    *(GAS v4u*)p = a; *(GAS v4u*)(p + 8) = b;
}
__device__ __forceinline__ void fin_ssm_row(const Args& A, const bf16* gsrow, bf16* oarow, int lane) {
    float v[16]; unpack16(gsrow + 16 * lane, v);
    float s = 0.f;
#pragma unroll
    for (int k = 0; k < 16; ++k) s += v[k] * v[k];
    s = wave_sum(s); const float rs = 1.0f / sqrtf(s * (1.0f / 1024.0f) + NEPS);
    const float* gn = A.in[I_SOUTG] + 16 * lane;
#pragma unroll
    for (int k = 0; k < 16; ++k) v[k] = v[k] * rs * gn[k];
    store16(oarow + 1024 + 16 * lane, v);
}
__device__ __forceinline__ void fin_prompt_row(const Args& A, int row, float lam, int lane) {
    unsigned char* ws = A.ws;
    float a[16], b2[16]; unpack16((const bf16*)(ws + WS_O1) + (size_t)row * 1024 + 16 * lane, a); unpack16((const bf16*)(ws + WS_O2) + (size_t)row * 1024 + 16 * lane, b2);
    float s = 0.f;
#pragma unroll
    for (int k = 0; k < 16; ++k) { a[k] = a[k] - lam * b2[k]; s += a[k] * a[k]; }
    s += __shfl_xor(s, 1); s += __shfl_xor(s, 2); s += __shfl_xor(s, 4);
    const float rs = (1.0f - LAM_INIT) / sqrtf(s * (1.0f / 128.0f) + SUBLN_EPS);
    const float* gn = A.in[I_SUBLNG] + 16 * lane;
#pragma unroll
    for (int k = 0; k < 16; ++k) a[k] = a[k] * rs * gn[k];
    bf16* oarow = (bf16*)(ws + WS_OA) + (size_t)row * 2048;
    store16(oarow + 16 * lane, a);
    fin_ssm_row(A, (const bf16*)(ws + WS_GS) + (size_t)row * 1024, oarow, lane);
}
__device__ __forceinline__ void fin_sample_attn(const Args& A, int task, float lam, LAS unsigned char* lds, int lane) {
    unsigned char* ws = A.ws; const int i = task & 3, h = (task >> 2) & 7, b = task >> 5, row = b * 4 + i;
    const LAS float* lut = (const LAS float*)(lds + LUT_OFF) + h * 130;
    const float* QS = (const float*)(ws + WS_QS); const float* KS = A.out + O_KS; const float* VS = A.out + O_VS;
    float o[2][2];
#pragma unroll
    for (int mp = 0; mp < 2; ++mp) {
        const float qv = QS[(size_t)row * 1024 + h * 128 + mp * 64 + lane];
        float sn[4];
#pragma unroll
        for (int j = 0; j < 4; ++j) { const float kv = KS[(size_t)(b * 4 + j) * 1024 + h * 128 + mp * 64 + lane]; sn[j] = wave_sum(qv * kv) + lut[(i - j) + 1 < 0 ? 0 : (i - j) + 1]; }
        const float* P = (const float*)(ws + WS_PART) + (size_t)((b * 8 + h) * 4) * 8 * 130 + (size_t)(i * 2 + mp) * 130;
        float mm = -INFINITY;
#pragma unroll
        for (int s = 0; s < 4; ++s) mm = fmaxf(mm, P[(size_t)s * 8 * 130]);
#pragma unroll
        for (int j = 0; j < 4; ++j) if (j <= i) mm = fmaxf(mm, sn[j]);
        float ll = 0.f, a0 = 0.f, a1 = 0.f;
#pragma unroll
        for (int s = 0; s < 4; ++s) { const float* ps = P + (size_t)s * 8 * 130; const float f = __builtin_amdgcn_exp2f(ps[0] - mm); ll += ps[1] * f; a0 += ps[2 + 2 * lane] * f; a1 += ps[3 + 2 * lane] * f; }
#pragma unroll
        for (int j = 0; j < 4; ++j) if (j <= i) { const float p = __builtin_amdgcn_exp2f(sn[j] - mm); const float* vr = VS + (size_t)(b * 4 + j) * 1024 + h * 128 + 2 * lane; ll += p; a0 += p * vr[0]; a1 += p * vr[1]; }
        const float inv = 1.0f / ll; o[mp][0] = a0 * inv; o[mp][1] = a1 * inv;
    }
    const float d0 = o[0][0] - lam * o[1][0], d1 = o[0][1] - lam * o[1][1];
    const float s = wave_sum(d0 * d0 + d1 * d1), rs = (1.0f - LAM_INIT) / sqrtf(s * (1.0f / 128.0f) + SUBLN_EPS);
    const float* gn = A.in[I_SUBLNG] + h * 128 + 2 * lane;
    *(GAS unsigned*)((bf16*)(ws + WS_OAS) + (size_t)row * 2048 + h * 128 + 2 * lane) = pk2(d0 * rs * gn[0], d1 * rs * gn[1]);
}

__device__ __forceinline__ void unpack8(v4u a, float (&v)[8]) { v[0] = bflo(a.x); v[1] = bfhi(a.x); v[2] = bflo(a.y); v[3] = bfhi(a.y); v[4] = bflo(a.z); v[5] = bfhi(a.z); v[6] = bflo(a.w); v[7] = bfhi(a.w); }
__device__ __forceinline__ float siluf_(float x) { return x * sigmoidf_(x); }
__device__ __forceinline__ void p4b_conv(const Args& A, int gtid, int nthreads) {
    unsigned char* ws = A.ws;
    const bf16* G = (const bf16*)(ws + WS_G); const bf16* V2 = (const bf16*)(ws + WS_V2); bf16* HFF = (bf16*)(ws + WS_HFF);
    constexpr int NCH = DFF / 8, RB = 32, NITEM = NCH * (TP / RB);
    for (int it = gtid; it < NITEM; it += nthreads) {
        const int ch = it % NCH, rb = it / NCH, c0 = ch * 8, r0 = rb * RB;
        float w0[8], w1[8], w2[8], cb[8];
#pragma unroll
        for (int k = 0; k < 8; ++k) { w0[k] = A.in[I_CONVW][c0 + k]; w1[k] = A.in[I_CONVW][DFF + c0 + k]; w2[k] = A.in[I_CONVW][2 * DFF + c0 + k]; cb[k] = A.in[I_CONVB][c0 + k]; }
        float gm2[8], gm1[8];
        if ((r0 & (SEQL - 1)) == 0) {
#pragma unroll
            for (int k = 0; k < 8; ++k) { gm2[k] = 0.f; gm1[k] = 0.f; }
        } else { unpack8(*(const GAS v4u*)(G + (size_t)(r0 - 2) * DFF + c0), gm2); unpack8(*(const GAS v4u*)(G + (size_t)(r0 - 1) * DFF + c0), gm1); }
#pragma unroll 4
        for (int rr = 0; rr < RB; ++rr) { const size_t o = (size_t)(r0 + rr) * DFF + c0;
            float g0[8], vv[8]; unpack8(*(const GAS v4u*)(G + o), g0); unpack8(*(const GAS v4u*)(V2 + o), vv);
            float hh[8];
#pragma unroll
            for (int k = 0; k < 8; ++k) { hh[k] = siluf_(cb[k] + w0[k] * gm2[k] + w1[k] * gm1[k] + w2[k] * g0[k]) * vv[k]; gm2[k] = gm1[k]; gm1[k] = g0[k]; }
            v4u w; w.x = pk2(hh[0], hh[1]); w.y = pk2(hh[2], hh[3]); w.z = pk2(hh[4], hh[5]); w.w = pk2(hh[6], hh[7]);
            *(GAS v4u*)(HFF + o) = w; }
    }
    const float* GU = (const float*)(ws + WS_GUS); const float* VU = (const float*)(ws + WS_VUS); bf16* HS = (bf16*)(ws + WS_HFFS);
    for (int it = gtid; it < TSM * DFF; it += nthreads) {
        const int row = it / DFF, j = it % DFF, bs = row >> 2, t = row & 3;
        const float* sc = A.in[I_SCONV] + (size_t)bs * 2 * DFF + j;
        const float x2 = GU[(size_t)row * DFF + j];
        const float x1 = t >= 1 ? GU[(size_t)(row - 1) * DFF + j] : sc[DFF];
        const float x0 = t >= 2 ? GU[(size_t)(row - 2) * DFF + j] : (t == 1 ? sc[DFF] : sc[0]);
        const float cv = A.in[I_CONVB][j] + A.in[I_CONVW][j] * x0 + A.in[I_CONVW][DFF + j] * x1 + A.in[I_CONVW][2 * DFF + j] * x2;
        HS[(size_t)row * DFF + j] = (bf16)f2bf(siluf_(cv) * VU[(size_t)row * DFF + j]);
    }
}
#ifndef PH_MASK
#define PH_MASK 0xFFFF
#endif
#define PHEN(k) (((PH_MASK) >> (k)) & 1)
__global__ void __launch_bounds__(NWAVES * 64, 2) hymba_fwd(Args args) {
    extern __shared__ __attribute__((aligned(16))) unsigned char lds_raw[];
    LAS unsigned char* lds = (LAS unsigned char*)lds_raw;
    const int G = gridDim.x;
    unsigned char* ws = args.ws;
#define PH_LOCALS() int tid = threadIdx.x; asm volatile("" : "+v"(tid)); int bx = blockIdx.x; asm volatile("" : "+s"(bx)); \
    const int lane = tid & 63, wave = __builtin_amdgcn_readfirstlane(tid >> 6), vcu = (G % 8 == 0) ? (bx % 8) * (G / 8) + bx / 8 : bx; \
    const int gw = vcu * NWAVES + wave, NGW = G * NWAVES, gtid = gw * 64 + lane, NT_ALL = NGW * 64; (void)lane; (void)wave; (void)vcu; (void)gw; (void)NGW; (void)gtid; (void)NT_ALL; (void)bx
    XcdBarrier bar;
    {
        PH_LOCALS();
        gu32* ctl = (gu32*)(ws + WS_CTL);
        for (int u = tid; u < (LDS_BYTES - LDSCTL_OFF) / 4; u += NWAVES * 64) ((LAS unsigned*)(lds + LDSCTL_OFF))[u] = 0u;
        __syncthreads();
        volatile LAS unsigned* MISC = (volatile LAS unsigned*)(lds + MISC_OFF);
        bar = xcd_barrier_post((unsigned*)(ctl + CW_BAR), MISC + 8);
    }

    if (PHEN(0)) { PH_LOCALS();
    p0_prologue(args, lds, vcu, G, wave, lane);
    }
    xcd_barrier(bar);

    {
        PH_LOCALS();
        for (int u = tid; u < 8 * 130; u += NTHR) ((LAS float*)(lds + LUT_OFF))[u] = ((const float*)(ws + WS_LUT))[u];
        __syncthreads();
    }

    if (PHEN(1)) { PH_LOCALS();
    {
        pg8::Gemm g{(const pg8::bf16_t*)(ws + WS_XB), (const pg8::bf16_t*)(ws + WS_WIN), TP, DIN, DMODEL}; pg8::StaticOrder S; S.init(TP, DIN, G, bx);
        pg8::EpiIn E{(const float*)(ws + WS_RSX), (pg8::bf16_t*)(ws + WS_QB), (pg8::bf16_t*)(ws + WS_KB), (pg8::bf16_t*)(ws + WS_VB), (float*)(ws + WS_US), args.out + O_KP, args.out + O_VP, C2F};
        pg8::gemm_phase<pg8::EpiIn, pg8::StaticOrder, true, true>(lds + RING_OFF, g, S, E);
    }
    {
        pg8::Gemm g{(const pg8::bf16_t*)(ws + WS_PB), (const pg8::bf16_t*)(ws + WS_WPP), TP, DMODEL, PLED}; pg8::StaticOrder S; S.init(TP, DMODEL, G, bx);
        pg8::EpiPlain E{(pg8::bf16_t*)(ws + WS_PROJ), DMODEL};
        pg8::gemm_phase<pg8::EpiPlain, pg8::StaticOrder, true, true>(lds + RING_OFF, g, S, E);
    }
    {
        const float* rsx = (const float*)(ws + WS_RSX) + TP; float* QS = (float*)(ws + WS_QS); float* USS = (float*)(ws + WS_USS); float* out = args.out;
        small_gemm(lds, (const bf16*)(ws + WS_XSB), (const bf16*)(ws + WS_WIN), DIN, DMODEL, vcu, G, nullptr, [=](int row, int col, float v) -> float {
            v *= rsx[row]; const int sec = col >> 10, c = col & 1023;
            if (sec == 0) QS[row * 1024 + c] = v * C2F; else if (sec == 1) out[O_KS + row * 1024 + c] = v; else if (sec == 2) out[O_VS + row * 1024 + c] = v; else USS[row * 1024 + c] = v;
            return v; });
        float* PJ = (float*)(ws + WS_PROJS);
        small_gemm(lds, (const bf16*)(ws + WS_PSB), (const bf16*)(ws + WS_WPP), DMODEL, PLED, vcu, G, nullptr, [=](int row, int col, float v) -> float { PJ[row * 2048 + col] = v; return v; });
    }
    }
    xcd_barrier(bar);

    if (PHEN(2)) { PH_LOCALS();
    if (PHEN(10)) { if (vcu < 256) decode_unit(args, vcu, lds, wave, lane); }
    if (PHEN(11)) {
        const attn_body::bf16* Qp = (const attn_body::bf16*)(ws + WS_QB); const attn_body::bf16* Kp = (const attn_body::bf16*)(ws + WS_KB); const attn_body::bf16* Vp = (const attn_body::bf16*)(ws + WS_VB);
        { const int L0 = vcu * 4;
            const int pair = L0 >> 4, s4 = (L0 >> 2) & 3, b = pair >> 5, vh = pair & 31, hh = vh >> 2, mp = (vh >> 1) & 1, vhalf = vh & 1;
            attn_body::bf16* Op = (attn_body::bf16*)(ws + (mp ? WS_O2 : WS_O1));
            for (int u = tid; u < 640; u += NTHR) { const int d = u - 256; ((LAS float*)(lds + LUTX_OFF))[u] = d < 0 ? -INFINITY : (d < 128 ? ((const LAS float*)(lds + LUT_OFF))[hh * 130 + 1 + d] : 0.f); }
            __syncthreads();
            attn_body::lds_cfptr lut = (attn_body::lds_cfptr)(lds + LUTX_OFF);
#pragma unroll 1
            for (int i = 0; i < 4; ++i) { const int qb = (i == 0) ? s4 : (i == 1) ? 7 - s4 : (i == 2) ? 8 + s4 : 15 - s4;
                attn_body::attn_unit<8>(b, 2 * hh + mp, 2 * hh + vhalf, qb, Qp, Kp, Vp, Op, (char*)lds_raw + RING_OFF, lut); }
        }
    }
    __syncthreads();
    if (PHEN(12)) { if (vcu < 128) ssm_prompt_unit(args, vcu >> 6, vcu & 63, lds, wave, lane); }
    if (PHEN(13)) { const int u = gw - 128 * NWAVES; if (u >= 0 && u < 512) ssm_sample_wave(args, u >> 6, u & 63, lds, wave, lane); }
    }
    xcd_barrier(bar);

    if (PHEN(3)) { PH_LOCALS(); const float lam = *(const float*)(ws + WS_LAM);
    for (int row = gw; row < TP; row += NGW) fin_prompt_row(args, row, lam, lane);
    for (int row = gw; row < TSM; row += NGW) fin_ssm_row(args, (const bf16*)(ws + WS_GSS) + (size_t)row * 1024, (bf16*)(ws + WS_OAS) + (size_t)row * 2048, lane);
    for (int t = NGW - 1 - gw; t < 256; t += NGW) fin_sample_attn(args, t, lam, lds, lane);
    }
    xcd_barrier(bar);

    if (PHEN(4)) { PH_LOCALS();
    {
        pg8::Gemm g{(const pg8::bf16_t*)(ws + WS_OA), (const pg8::bf16_t*)(ws + WS_WOUT), TP, DMODEL, DMODEL}; pg8::StaticOrder S; S.init(TP, DMODEL, G, bx);
        pg8::EpiRes<0> E{args.in[I_XP], (float*)(ws + WS_H1), (pg8::bf16_t*)(ws + WS_H1B), (float*)(ws + WS_SS1), nullptr, nullptr};
        if (G == 256) pg8::gemm_phase<pg8::EpiRes<0>, pg8::StaticOrder, false, true>(lds + RING_OFF, g, S, E);
        const float* xs = args.in[I_XS]; float* H1S = (float*)(ws + WS_H1S); bf16* H1SB = (bf16*)(ws + WS_H1SB);
        small_gemm(lds, (const bf16*)(ws + WS_OAS), (const bf16*)(ws + WS_WOUT), DMODEL, DMODEL, vcu, G, (float*)(ws + WS_SS1S), [=](int row, int col, float v) -> float {
            const float h = xs[row * 2048 + col] + v; H1S[row * 2048 + col] = h; H1SB[row * 2048 + col] = (bf16)f2bf(h); return h; });
    }
    }
    xcd_barrier(bar);

    if (PHEN(5)) { PH_LOCALS();
    {
        pg8::Gemm g{(const pg8::bf16_t*)(ws + WS_H1B), (const pg8::bf16_t*)(ws + WS_WUP), TP, 2 * DFF, DMODEL}; pg8::StaticOrder S; S.init(TP, 2 * DFF, G, bx);
        pg8::EpiUp E{(const float*)(ws + WS_SS1), (pg8::bf16_t*)(ws + WS_G), (pg8::bf16_t*)(ws + WS_V2), args.out + O_CONVP, DFF};
        pg8::gemm_phase<pg8::EpiUp, pg8::StaticOrder, true, true>(lds + RING_OFF, g, S, E);
        sample_rstd_table(lds, (const float*)(ws + WS_SS1S));
        const LAS float* RS = (const LAS float*)(lds + RS_OFF); float* GU = (float*)(ws + WS_GUS); float* VU = (float*)(ws + WS_VUS); float* out = args.out;
        small_gemm(lds, (const bf16*)(ws + WS_H1SB), (const bf16*)(ws + WS_WUP), 2 * DFF, DMODEL, vcu, G, nullptr, [=](int row, int col, float v) -> float {
            v *= RS[row]; const int j = (col >> 8) * 128 + (col & 127);
            if (col & 128) VU[row * DFF + j] = v; else { GU[row * DFF + j] = v; if ((row & 3) >= 2) out[O_CONVS + (size_t)((row >> 2) * 2 + (row & 3) - 2) * DFF + j] = v; }
            return v; });
    }
    }
    xcd_barrier(bar);

    if (PHEN(6)) { PH_LOCALS();
    p4b_conv(args, gtid, NT_ALL);
    }
    xcd_barrier(bar);

    if (PHEN(7)) { PH_LOCALS();
    {
        pg8::Gemm g{(const pg8::bf16_t*)(ws + WS_HFF), (const pg8::bf16_t*)(ws + WS_WDN), TP, DMODEL, DFF}; pg8::StaticOrder S; S.init(TP, DMODEL, G, bx);
        pg8::EpiRes<0> E{(const float*)(ws + WS_H1), (float*)(ws + WS_H2), (pg8::bf16_t*)(ws + WS_H2B), (float*)(ws + WS_SS2), nullptr, nullptr};
        if (G == 256) pg8::gemm_phase<pg8::EpiRes<0>, pg8::StaticOrder, false, true>(lds + RING_OFF, g, S, E);
        const float* H1S = (const float*)(ws + WS_H1S); float* H2S = (float*)(ws + WS_H2S); bf16* H2SB = (bf16*)(ws + WS_H2SB);
        small_gemm(lds, (const bf16*)(ws + WS_HFFS), (const bf16*)(ws + WS_WDN), DMODEL, DFF, vcu, G, (float*)(ws + WS_SS2S), [=](int row, int col, float v) -> float {
            const float h = H1S[row * 2048 + col] + v; H2S[row * 2048 + col] = h; H2SB[row * 2048 + col] = (bf16)f2bf(h); return h; });
    }
    }
    xcd_barrier(bar);

    if (PHEN(8)) { PH_LOCALS();
    {
        pg8::Gemm g{(const pg8::bf16_t*)(ws + WS_H2B), (const pg8::bf16_t*)(ws + WS_WPG), TP, DMODEL, DMODEL}; pg8::StaticOrder S; S.init(TP, DMODEL, G, bx);
        pg8::EpiRes<1> E{(const float*)(ws + WS_H2), args.out + O_YP, nullptr, (float*)(ws + WS_SS3), (const float*)(ws + WS_SS2), (const pg8::bf16_t*)(ws + WS_PROJ)};
        if (G == 256) pg8::gemm_phase<pg8::EpiRes<1>, pg8::StaticOrder, false, true>(lds + RING_OFF, g, S, E);
        sample_rstd_table(lds, (const float*)(ws + WS_SS2S));
        const LAS float* RS = (const LAS float*)(lds + RS_OFF); const float* H2S = (const float*)(ws + WS_H2S); const float* PJ = (const float*)(ws + WS_PROJS); float* out = args.out;
        small_gemm(lds, (const bf16*)(ws + WS_H2SB), (const bf16*)(ws + WS_WPG), DMODEL, DMODEL, vcu, G, (float*)(ws + WS_SS3S), [=](int row, int col, float v) -> float {
            const float h = H2S[row * 2048 + col] + sigmoidf_(v * RS[row]) * PJ[row * 2048 + col]; out[O_YS + row * 2048 + col] = h; return h; });
    }
    }
    xcd_barrier(bar);

    if (PHEN(9)) { PH_LOCALS();
    for (int row = gw; row < TP + TSM; row += NGW) {
        float* yrow; float rs;
        if (row < TP) { yrow = args.out + O_YP + (size_t)row * DMODEL; rs = pg8::rstd8((const float*)(ws + WS_SS3) + (size_t)row * 8); }
        else { const int r = row - TP; yrow = args.out + O_YS + (size_t)r * DMODEL; const float* ss = (const float*)(ws + WS_SS3S) + r * 128; const float q = wave_sum(ss[lane] + ss[64 + lane]); rs = 1.0f / sqrtf(q * (1.0f / 2048.0f) + NEPS); }
        GAS f32x4* yr = (GAS f32x4*)yrow + lane; const GAS f32x4* gn = (const GAS f32x4*)args.in[I_NFING] + lane;
#pragma unroll
        for (int j = 0; j < 8; ++j) { f32x4 v = yr[64 * j]; const f32x4 g4 = gn[64 * j]; v = v * rs * g4; yr[64 * j] = v; }
    }
    }
}

extern "C" void kernel_launch(void* const* d_in, const int* in_sizes, int n_in, void* d_out, int out_size, void* d_ws, size_t ws_size, hipStream_t stream) {
    static int grid = 0;
    if (grid == 0) {
        if (n_in != N_IN || (size_t)out_size != O_END || ws_size < WS_END) { fprintf(stderr, "kernel_launch: unexpected shapes: n_in %d out %d ws %zu (need %d, %zu, %zu)\n", n_in, out_size, ws_size, (int)N_IN, (size_t)O_END, (size_t)WS_END); grid = -1; return; }
        int dev = 0, cus = 0, per_cu = 0;
        if (hipGetDevice(&dev) != hipSuccess || hipDeviceGetAttribute(&cus, hipDeviceAttributeMultiprocessorCount, dev) != hipSuccess) { grid = -1; return; }
        if (hipFuncSetAttribute((const void*)hymba_fwd, hipFuncAttributeMaxDynamicSharedMemorySize, LDS_BYTES) != hipSuccess) { fprintf(stderr, "kernel_launch: hipFuncSetAttribute failed\n"); grid = -1; return; }
        if (hipOccupancyMaxActiveBlocksPerMultiprocessor(&per_cu, (const void*)hymba_fwd, NWAVES * 64, LDS_BYTES) != hipSuccess || per_cu < 1) fprintf(stderr, "kernel_launch: occupancy query reports %d\n", per_cu);
        (void)hipGetLastError();
        grid = cus;
        if (grid != 256) fprintf(stderr, "kernel_launch: %d CUs (built for 256)\n", grid);
    }
    if (grid < 0) return;
    if (hipMemsetAsync((char*)d_ws + WS_CTL, 0, CTL_ZERO_BYTES, stream) != hipSuccess) return;
    Args a{};
    for (int i = 0; i < N_IN; ++i) a.in[i] = (const float*)d_in[i];
    a.out = (float*)d_out; a.ws = (unsigned char*)d_ws;
    hipLaunchKernelGGL(hymba_fwd, dim3(grid), dim3(NWAVES * 64), LDS_BYTES, stream, a);
}
```

```cpp
#include <hip/hip_runtime.h>
#include <hip/hip_bf16.h>
#include <cstdio>
#include <cstdint>
#include <cmath>
namespace pg8 {
#define PG8_LAS __attribute__((address_space(3)))
typedef unsigned short bf16_t;
typedef short bf16x8 __attribute__((ext_vector_type(8)));
typedef float f32x4 __attribute__((ext_vector_type(4)));
typedef unsigned u32x4 __attribute__((ext_vector_type(4)));
constexpr int BM = 256, BK = 64, HALF = 128, HTB = HALF * BK * 2  , STAGE_BYTES = 8 * HTB, NXCD = 8, WGM = 8;

__host__ __device__ __forceinline__ int lds_byte(int r, int c) { const int st = (r >> 4) * 2 + (c >> 5), rr = r & 15, cc = c & 31, ob = rr * 64 + cc * 2; return st * 1024 + (ob ^ (((ob >> 9) & 1) << 5)); }
__host__ __device__ __forceinline__ void stage_rc(int b, int& R, int& C) { const int st = b / 1024, sb = b % 1024, swz = sb ^ (((sb >> 9) & 1) << 5); R = (st >> 1) * 16 + swz / 64; C = (st & 1) * 32 + (swz % 64) / 2; }
__host__ __device__ __forceinline__ int perm32(int rho) { const int n = rho >> 4, i = rho & 15; return 8 * (i >> 2) + 4 * n + (i & 3); }

struct Unit { int pm, pn; };
struct Gemm { const bf16_t* A; const bf16_t* Bt; int M, N, K; };

struct StaticOrder {
    int nM, nN, nwg, G, c;
    __host__ __device__ void init(int M, int N, int G_, int c_) { nM = M / BM; nN = N / BM; nwg = nM * nN; G = G_; c = c_; }
    __host__ __device__ bool next(int i, Unit& u) const {
        const long L = (long)i * G + c; if (L >= nwg) return false;
        int wgid = (int)L; { const int q = nwg / NXCD, r = nwg % NXCD, xcd = wgid % NXCD, off = wgid / NXCD; wgid = (xcd < r ? xcd * (q + 1) : r * (q + 1) + (xcd - r) * q) + off; }
        const int nig = WGM * nN, gid = wgid / nig, fm = gid * WGM, gsz = (nM - fm) < WGM ? (nM - fm) : WGM;
        u.pm = fm + ((wgid % nig) % gsz); u.pn = (wgid % nig) / gsz; return true;
    }
    __device__ __forceinline__ void a_ready(const Unit&) const {}
    __device__ __forceinline__ void done(const Unit&) const {}
};

__device__ __forceinline__ unsigned cvt_pk_bf16(float lo, float hi) { unsigned r; asm volatile("v_cvt_pk_bf16_f32 %0, %1, %2" : "=v"(r) : "v"(lo), "v"(hi)); return r; }
typedef float f32x2 __attribute__((ext_vector_type(2)));
__device__ __forceinline__ f32x2 gelu_pk(f32x2 v) {
    const f32x2 av = __builtin_elementwise_abs(v), d = av * 0.2316418882f + 1.0f;
    f32x2 t; t.x = __builtin_amdgcn_rcpf(d.x); t.y = __builtin_amdgcn_rcpf(d.y);
    f32x2 q = t * 0.5307027145f + (-0.7265760135f); q = q * t + 0.7107068705f; q = q * t + (-0.142248368f); q = q * t + 0.127414796f; q = q * t;
    const f32x2 s = (v * v) * (-0.72134752044f);
    f32x2 e; e.x = __builtin_amdgcn_exp2f(s.x); e.y = __builtin_amdgcn_exp2f(s.y);
    const f32x2 m = v * (q * e), r = v - m;
    f32x2 o; o.x = v.x < 0.f ? m.x : r.x; o.y = v.y < 0.f ? m.y : r.y; return o;
}

constexpr float NORM_EPS_ = 1e-6f;
__device__ __forceinline__ u32x4 pack8(f32x4 a, f32x4 b) { u32x4 w; w.x = cvt_pk_bf16(a[0], a[1]); w.y = cvt_pk_bf16(a[2], a[3]); w.z = cvt_pk_bf16(b[0], b[1]); w.w = cvt_pk_bf16(b[2], b[3]); return w; }
__device__ __forceinline__ float rstd8(const float* ss) { const f32x4 a = *(const f32x4*)ss, b = *(const f32x4*)(ss + 4); return 1.0f / sqrtf((((a[0] + a[1]) + (a[2] + a[3])) + ((b[0] + b[1]) + (b[2] + b[3]))) * (1.0f / 2048.0f) + NORM_EPS_); }
__device__ __forceinline__ float bf_lo(unsigned w) { return __uint_as_float(w << 16); }
__device__ __forceinline__ float bf_hi(unsigned w) { return __uint_as_float(w & 0xffff0000u); }

struct EpiIn {
    static constexpr bool PERM = true, AFTER_DRAIN = false;
    const float* rstd; bf16_t* QB; bf16_t* KB; bf16_t* VB; float* US; float* Kout; float* Vout; float qscale;
    __device__ __forceinline__ void operator()(const f32x4 (&acc)[2][2][4][2], const Unit& u, int wr, int wc, int fr, int fq) const {
        { int t_ = threadIdx.x; asm volatile("" : "+v"(t_)); fr = t_ & 15; fq = (t_ >> 4) & 3; }
        const int row0 = u.pm * BM + wr * 64 + fr, sec = u.pn >> 2, col0 = (u.pn & 3) * BM + wc * 32 + 8 * fq;
#pragma unroll
        for (int ai = 0; ai < 2; ++ai)
#pragma unroll
            for (int m = 0; m < 4; ++m) { const int row = row0 + ai * HALF + m * 16; const float rs = rstd[row]; const size_t o = (size_t)row * 1024 + col0;
#pragma unroll
                for (int bj = 0; bj < 2; ++bj) { f32x4 v0 = acc[ai][bj][m][0] * rs, v1 = acc[ai][bj][m][1] * rs; const size_t oo = o + bj * HALF;
                    if (sec == 0) { v0 = v0 * qscale; v1 = v1 * qscale; *(u32x4*)(QB + oo) = pack8(v0, v1); }
                    else if (sec == 1) { *(f32x4*)(Kout + oo) = v0; *(f32x4*)(Kout + oo + 4) = v1; *(u32x4*)(KB + oo) = pack8(v0, v1); }
                    else if (sec == 2) { *(f32x4*)(Vout + oo) = v0; *(f32x4*)(Vout + oo + 4) = v1; *(u32x4*)(VB + oo) = pack8(v0, v1); }
                    else { *(f32x4*)(US + oo) = v0; *(f32x4*)(US + oo + 4) = v1; } } }
    }
};
struct EpiPlain {
    static constexpr bool PERM = true, AFTER_DRAIN = false;
    bf16_t* O; int ldc;
    __device__ __forceinline__ void operator()(const f32x4 (&acc)[2][2][4][2], const Unit& u, int wr, int wc, int fr, int fq) const {
        { int t_ = threadIdx.x; asm volatile("" : "+v"(t_)); fr = t_ & 15; fq = (t_ >> 4) & 3; }
        const int row0 = u.pm * BM + wr * 64 + fr, col0 = u.pn * BM + wc * 32 + 8 * fq;
#pragma unroll
        for (int ai = 0; ai < 2; ++ai)
#pragma unroll
            for (int m = 0; m < 4; ++m) { bf16_t* rowp = O + (size_t)(row0 + ai * HALF + m * 16) * ldc + col0;
#pragma unroll
                for (int bj = 0; bj < 2; ++bj) *(u32x4*)(rowp + bj * HALF) = pack8(acc[ai][bj][m][0], acc[ai][bj][m][1]); }
    }
};
template <int CTRL> __device__ __forceinline__ float dppf_(float x) { return __builtin_bit_cast(float, __builtin_amdgcn_update_dpp(0, __builtin_bit_cast(int, x), CTRL, 0xf, 0xf, true)); }
struct EpiUpConv {
    static constexpr bool PERM = true, AFTER_DRAIN = false;
    const float* ssin; bf16_t* HFF; float* conv_out; const float* cw; const float* cb; float* GF; float* VF; float* GL; PG8_LAS float* HAL; int ldf;
    __device__ __forceinline__ void operator()(const f32x4 (&acc)[2][2][4][2], const Unit& u, int wr, int wc, int fr, int fq) const {
        { int t_ = threadIdx.x; asm volatile("" : "+v"(t_)); fr = t_ & 15; fq = (t_ >> 4) & 3; }
        const int row0 = u.pm * BM + wr * 64 + fr, col0 = u.pn * HALF + wc * 32 + 8 * fq;
        float w0[8], w1[8], w2[8], cbv[8];
#pragma unroll
        for (int h = 0; h < 2; ++h) { const f32x4 a = *(const f32x4*)(cw + col0 + 4 * h), b = *(const f32x4*)(cw + ldf + col0 + 4 * h), c = *(const f32x4*)(cw + 2 * ldf + col0 + 4 * h), d = *(const f32x4*)(cb + col0 + 4 * h);
#pragma unroll
            for (int e = 0; e < 4; ++e) { w0[4 * h + e] = a[e]; w1[4 * h + e] = b[e]; w2[4 * h + e] = c[e]; cbv[4 * h + e] = d[e]; } }
        float rsl[2];
#pragma unroll
        for (int ai = 0; ai < 2; ++ai) { rsl[ai] = rstd8(ssin + (size_t)(row0 + ai * HALF + 48) * 8);
            if (fr >= 14) { PG8_LAS float* dst = HAL + ((((wr * 4 + wc) * 2 + ai) * 2 + (fr - 14)) * 32 + 8 * fq);
                *(PG8_LAS f32x4*)dst = acc[ai][0][3][0] * rsl[ai]; *(PG8_LAS f32x4*)(dst + 4) = acc[ai][0][3][1] * rsl[ai]; } }
        asm volatile("s_waitcnt lgkmcnt(0)" ::: "memory"); __builtin_amdgcn_s_barrier(); asm volatile("" ::: "memory");
#pragma unroll
        for (int ai = 0; ai < 2; ++ai) {
            float pg[8];
            float h1[8], h2[8];
            { const int swr = wr == 1 ? 0 : 1, sai = wr == 1 ? ai : 0; const bool have = (wr == 1) || (ai == 1);
              const PG8_LAS float* src = HAL + ((((swr * 4 + wc) * 2 + sai) * 2) * 32 + 8 * fq);
#pragma unroll
              for (int e = 0; e < 8; ++e) { h2[e] = have ? src[e] : 0.f; h1[e] = have ? src[32 + e] : 0.f; } }
#pragma unroll
            for (int m = 0; m < 4; ++m) { const int row = row0 + ai * HALF + m * 16; const float rs = (m == 3) ? rsl[ai] : rstd8(ssin + (size_t)row * 8); const size_t o = (size_t)row * ldf + col0;
                float g[8], v[8], hh[8];
#pragma unroll
                for (int e = 0; e < 4; ++e) { g[e] = acc[ai][0][m][0][e] * rs; g[4 + e] = acc[ai][0][m][1][e] * rs; v[e] = acc[ai][1][m][0][e] * rs; v[4 + e] = acc[ai][1][m][1][e] * rs; }
#pragma unroll
                for (int e = 0; e < 8; ++e) {
                    const float c1 = dppf_<0x121>(g[e]), c2 = dppf_<0x122>(g[e]);
                    float p1, p2;
                    if (m == 0) { p1 = h1[e]; p2 = fr == 0 ? h2[e] : h1[e]; }
                    else { p1 = dppf_<0x121>(pg[e]); p2 = dppf_<0x122>(pg[e]); }
                    const float g1 = fr >= 1 ? c1 : p1, g2 = fr >= 2 ? c2 : p2;
                    const float cv = cbv[e] + w0[e] * g2 + w1[e] * g1 + w2[e] * g[e];
                    hh[e] = cv * __builtin_amdgcn_rcpf(1.f + __builtin_amdgcn_exp2f(-1.4426950408889634f * cv)) * v[e]; }
                u32x4 w; w.x = cvt_pk_bf16(hh[0], hh[1]); w.y = cvt_pk_bf16(hh[2], hh[3]); w.z = cvt_pk_bf16(hh[4], hh[5]); w.w = cvt_pk_bf16(hh[6], hh[7]);
                *(u32x4*)(HFF + o) = w;
                const int rl = ai * HALF + wr * 64 + m * 16 + fr, tt = row & 4095;
                if (rl < 2) { float* gf = GF + (size_t)(u.pm * 2 + rl) * ldf + col0; float* vf = VF + (size_t)(u.pm * 2 + rl) * ldf + col0;
                    *(f32x4*)gf = (f32x4){g[0], g[1], g[2], g[3]}; *(f32x4*)(gf + 4) = (f32x4){g[4], g[5], g[6], g[7]}; *(f32x4*)vf = (f32x4){v[0], v[1], v[2], v[3]}; *(f32x4*)(vf + 4) = (f32x4){v[4], v[5], v[6], v[7]}; }
                if (rl >= 254) { float* gl = GL + (size_t)(u.pm * 2 + rl - 254) * ldf + col0; *(f32x4*)gl = (f32x4){g[0], g[1], g[2], g[3]}; *(f32x4*)(gl + 4) = (f32x4){g[4], g[5], g[6], g[7]}; }
                if (tt >= 4094) { float* co = conv_out + (size_t)((row >> 12) * 2 + (tt - 4094)) * ldf + col0; *(f32x4*)co = (f32x4){g[0], g[1], g[2], g[3]}; *(f32x4*)(co + 4) = (f32x4){g[4], g[5], g[6], g[7]}; }
#pragma unroll
                for (int e = 0; e < 8; ++e) pg[e] = g[e];
            }
        }
    }
};
template <int MODE> struct EpiRes {
    static constexpr bool PERM = true, AFTER_DRAIN = true;
    const float* base; float* outf; bf16_t* outb; float* ss; const float* ssin; const bf16_t* proj;
    __device__ __forceinline__ void fused(f32x4 (&acc)[2][2][4][2], const Unit& u, int wr, int wc, int fr, int fq, PG8_LAS unsigned char* lds, int wid, int lane) const {
        { int t_ = threadIdx.x; asm volatile("" : "+v"(t_)); fr = t_ & 15; fq = (t_ >> 4) & 3; }
        PG8_LAS float* P = (PG8_LAS float*)lds;
        const int col0 = u.pn * BM + wc * 32 + 8 * fq;
#pragma unroll
        for (int ai = 0; ai < 2; ++ai)
#pragma unroll
            for (int m = 0; m < 4; ++m) { const int rl = ai * HALF + wr * 64 + m * 16 + fr, row = u.pm * BM + rl; const size_t o = (size_t)row * 2048 + col0;
                float rs = 1.f; if (MODE == 1) rs = rstd8(ssin + (size_t)row * 8);
                float sq = 0.f;
#pragma unroll
                for (int bj = 0; bj < 2; ++bj) { const size_t oo = o + bj * HALF; f32x4 a0 = acc[ai][bj][m][0], a1 = acc[ai][bj][m][1];
                    const f32x4 b0 = *(const f32x4*)(base + oo), b1 = *(const f32x4*)(base + oo + 4);
                    if (MODE == 1) { const u32x4 pw = *(const u32x4*)(proj + oo);
                        const f32x4 p0 = {bf_lo(pw.x), bf_hi(pw.x), bf_lo(pw.y), bf_hi(pw.y)}, p1 = {bf_lo(pw.z), bf_hi(pw.z), bf_lo(pw.w), bf_hi(pw.w)};
#pragma unroll
                        for (int e = 0; e < 4; ++e) { a0[e] = p0[e] * __builtin_amdgcn_rcpf(1.f + __builtin_amdgcn_exp2f(-1.4426950408889634f * rs * a0[e])); a1[e] = p1[e] * __builtin_amdgcn_rcpf(1.f + __builtin_amdgcn_exp2f(-1.4426950408889634f * rs * a1[e])); } }
                    const f32x4 h0 = b0 + a0, h1 = b1 + a1;
                    *(f32x4*)(outf + oo) = h0; *(f32x4*)(outf + oo + 4) = h1;
                    if (outb) *(u32x4*)(outb + oo) = pack8(h0, h1);
                    sq += (h0[0] * h0[0] + h0[1] * h0[1]) + (h0[2] * h0[2] + h0[3] * h0[3]) + (h1[0] * h1[0] + h1[1] * h1[1]) + (h1[2] * h1[2] + h1[3] * h1[3]); }
                sq += __shfl_xor(sq, 16); sq += __shfl_xor(sq, 32);
                if (fq == 0) P[rl * 4 + wc] = sq; }
        asm volatile("s_waitcnt lgkmcnt(0)" ::: "memory"); __builtin_amdgcn_s_barrier(); asm volatile("" ::: "memory");
        const int t = wid * 64 + lane;
        if (t < 256) { const f32x4 p = *(const PG8_LAS f32x4*)(P + t * 4); ss[(size_t)(u.pm * BM + t) * 8 + u.pn] = (p[0] + p[1]) + (p[2] + p[3]); }
        asm volatile("s_waitcnt lgkmcnt(0)" ::: "memory"); __builtin_amdgcn_s_barrier(); asm volatile("" ::: "memory");
    }
};
template <class Epi, class Sched, bool ALIGN_EPI = false, bool SP2 = false>
__device__ __forceinline__ void gemm_phase(PG8_LAS unsigned char* lds, const Gemm g, const Sched& S, const Epi& E) {
    int tid_o = threadIdx.x; asm volatile("" : "+v"(tid_o));
    const int tid = tid_o, wid = __builtin_amdgcn_readfirstlane(tid >> 6), lane = tid & 63, wr = wid >> 2, wc = wid & 3, fr = lane & 15, fq = lane >> 4;
    const int K = g.K, nt = K / BK;
    unsigned voffA[2], voffB[2];
#pragma unroll
    for (int i = 0; i < 2; ++i) { int R, C; stage_rc(tid * 16 + i * 8192, R, C); const int Rb = Epi::PERM ? ((R & ~31) + perm32(R & 31)) : R;
        voffA[i] = (unsigned)(R * K + C) * 2u; voffB[i] = (unsigned)(Rb * K + C) * 2u; }
    const size_t kstep = (size_t)(BK * 2);
    const size_t hstep = (size_t)HALF * K * 2;
    const size_t tstep = 2 * hstep;
    const unsigned ldsw = (unsigned)wid * 1024u;
    const int aoff = lds_byte(wr * 64 + fr, fq * 8), boff = lds_byte(wc * 32 + fr, fq * 8);
#define PG8_SA(b, h) (((b) * 2 + (h)) * HTB)
#define PG8_SB(b, h) ((4 + (b) * 2 + (h)) * HTB)
#define PG8_STAGE(bufoff, gbase, voff) do { _Pragma("unroll") for (int _i = 0; _i < 2; ++_i) \
        __builtin_amdgcn_global_load_lds((const unsigned*)((const char*)(gbase) + (voff)[_i]), (PG8_LAS unsigned*)(lds + (bufoff) + ldsw + _i * 8192), 16, 0, 0); } while (0)
#define PG8_LDA(dst, b, h) do { _Pragma("unroll") for (int m = 0; m < 4; ++m) _Pragma("unroll") for (int k = 0; k < 2; ++k) dst[m][k] = *(const PG8_LAS bf16x8*)(lds + PG8_SA(b, h) + aoff + m * 2048 + k * 1024); } while (0)
#define PG8_LDB(dst, b, h) do { _Pragma("unroll") for (int n = 0; n < 2; ++n) _Pragma("unroll") for (int k = 0; k < 2; ++k) dst[n][k] = *(const PG8_LAS bf16x8*)(lds + PG8_SB(b, h) + boff + n * 2048 + k * 1024); } while (0)
#define PG8_MMA(ai, bj, At, Bt) do { __builtin_amdgcn_s_setprio(1); _Pragma("unroll") for (int m = 0; m < 4; ++m) _Pragma("unroll") for (int n = 0; n < 2; ++n) _Pragma("unroll") for (int k = 0; k < 2; ++k) \
        acc[ai][bj][m][n] = __builtin_amdgcn_mfma_f32_16x16x32_bf16(Bt[n][k], At[m][k], acc[ai][bj][m][n], 0, 0, 0); __builtin_amdgcn_s_setprio(0); } while (0)
#define PG8_WAIT_V(n) asm volatile("s_waitcnt vmcnt(" #n ")" ::: "memory")
#define PG8_WAIT_L(n) asm volatile("s_waitcnt lgkmcnt(" #n ")" ::: "memory")
#define PG8_BAR __builtin_amdgcn_s_barrier()
#define PG8_SCHED __builtin_amdgcn_sched_barrier(0)
    Unit cur, nxt; int ui = 0;
    if (!S.next(0, cur)) return;
    f32x4 acc[2][2][4][2];
#pragma unroll
    for (int a = 0; a < 2; ++a)
#pragma unroll
        for (int b = 0; b < 2; ++b)
#pragma unroll
            for (int m = 0; m < 4; ++m)
#pragma unroll
                for (int n = 0; n < 2; ++n) acc[a][b][m][n] = (f32x4){0.f, 0.f, 0.f, 0.f};
    bf16x8 At[4][2], B0[2][2], B1[2][2];
    const char* cA = (const char*)g.A + (size_t)cur.pm * tstep; const char* cB = (const char*)g.Bt + (size_t)cur.pn * tstep;
    S.a_ready(cur);
    if constexpr (SP2) {
        PG8_STAGE(PG8_SB(0, 0), cB, voffB); PG8_STAGE(PG8_SB(0, 1), cB + hstep, voffB); PG8_STAGE(PG8_SA(0, 0), cA, voffA); PG8_STAGE(PG8_SA(0, 1), cA + hstep, voffA);
        if (wr == 1) PG8_BAR;
        PG8_WAIT_V(2); PG8_BAR;
        PG8_STAGE(PG8_SB(1, 0), cB + kstep, voffB); PG8_STAGE(PG8_SA(1, 0), cA + kstep, voffA); PG8_STAGE(PG8_SB(1, 1), cB + hstep + kstep, voffB);
        PG8_WAIT_V(6); PG8_BAR;
    } else {
        PG8_STAGE(PG8_SB(0, 0), cB, voffB); PG8_STAGE(PG8_SA(0, 0), cA, voffA); PG8_STAGE(PG8_SB(0, 1), cB + hstep, voffB); PG8_STAGE(PG8_SA(0, 1), cA + hstep, voffA);
        if (wr == 1) PG8_BAR;
        PG8_WAIT_V(4); PG8_BAR;
        PG8_STAGE(PG8_SB(1, 0), cB + kstep, voffB); PG8_STAGE(PG8_SA(1, 0), cA + kstep, voffA); PG8_STAGE(PG8_SB(1, 1), cB + hstep + kstep, voffB);
        PG8_WAIT_V(6); PG8_BAR;
    }
    for (;;) {
        const bool has_next = S.next(ui + 1, nxt);
        const char* nA = has_next ? (const char*)g.A + (size_t)nxt.pm * tstep : cA; const char* nB = has_next ? (const char*)g.Bt + (size_t)nxt.pn * tstep : cB;
        for (int t = 0; t < nt; t += 2) {
            const bool last = (t == nt - 2);
            const char* a1 = cA + (size_t)(t + 1) * kstep;
            const char* a2 = last ? nA : cA + (size_t)(t + 2) * kstep; const char* b2 = last ? nB : cB + (size_t)(t + 2) * kstep;
            const char* a3 = a2 + kstep; const char* b3 = b2 + kstep;
            if (last && has_next) S.a_ready(nxt);
            if constexpr (SP2) {
            PG8_LDB(B0, 0, 0); PG8_LDB(B1, 0, 1); PG8_SCHED; PG8_LDA(At, 0, 0); PG8_STAGE(PG8_SA(1, 1), a1 + hstep, voffA);
            PG8_WAIT_V(8); PG8_WAIT_L(0); PG8_BAR; PG8_MMA(0, 0, At, B0); PG8_MMA(0, 1, At, B1); PG8_BAR; PG8_SCHED;
            PG8_LDA(At, 0, 1); PG8_STAGE(PG8_SB(0, 0), b2, voffB); PG8_STAGE(PG8_SB(0, 1), b2 + hstep, voffB); PG8_STAGE(PG8_SA(0, 0), a2, voffA);
            PG8_WAIT_V(8); PG8_WAIT_L(0); PG8_BAR; PG8_MMA(1, 0, At, B0); PG8_MMA(1, 1, At, B1); PG8_BAR; PG8_SCHED;
            PG8_LDB(B0, 1, 0); PG8_LDB(B1, 1, 1); PG8_SCHED; PG8_LDA(At, 1, 0); PG8_STAGE(PG8_SA(0, 1), a2 + hstep, voffA);
            PG8_WAIT_V(8); PG8_WAIT_L(0); PG8_BAR; PG8_MMA(0, 0, At, B0); PG8_MMA(0, 1, At, B1); PG8_BAR; PG8_SCHED;
            PG8_LDA(At, 1, 1); PG8_STAGE(PG8_SB(1, 0), b3, voffB); PG8_STAGE(PG8_SB(1, 1), b3 + hstep, voffB); PG8_STAGE(PG8_SA(1, 0), a3, voffA);
            PG8_WAIT_V(8); PG8_WAIT_L(0); PG8_BAR; PG8_MMA(1, 0, At, B0); PG8_MMA(1, 1, At, B1); PG8_BAR; PG8_SCHED;
            } else {
            PG8_LDB(B0, 0, 0); PG8_SCHED; PG8_LDA(At, 0, 0); PG8_STAGE(PG8_SA(1, 1), a1 + hstep, voffA);
            PG8_WAIT_L(8); PG8_BAR; PG8_WAIT_L(0); PG8_MMA(0, 0, At, B0); PG8_BAR; PG8_SCHED;
            PG8_LDB(B1, 0, 1); PG8_STAGE(PG8_SB(0, 0), b2, voffB);
            PG8_BAR; PG8_WAIT_L(0); PG8_MMA(0, 1, At, B1); PG8_BAR;
            PG8_LDA(At, 0, 1); PG8_STAGE(PG8_SA(0, 0), a2, voffA);
            PG8_BAR; PG8_WAIT_L(0); PG8_MMA(1, 0, At, B0); PG8_BAR; PG8_SCHED;
            PG8_STAGE(PG8_SB(0, 1), b2 + hstep, voffB);
            PG8_WAIT_V(6); PG8_BAR; PG8_MMA(1, 1, At, B1); PG8_BAR;
            PG8_LDB(B0, 1, 0); PG8_SCHED; PG8_LDA(At, 1, 0); PG8_STAGE(PG8_SA(0, 1), a2 + hstep, voffA);
            PG8_WAIT_L(8); PG8_BAR; PG8_WAIT_L(0); PG8_MMA(0, 0, At, B0); PG8_BAR; PG8_SCHED;
            PG8_LDB(B1, 1, 1); PG8_STAGE(PG8_SB(1, 0), b3, voffB);
            PG8_BAR; PG8_WAIT_L(0); PG8_MMA(0, 1, At, B1); PG8_BAR;
            PG8_LDA(At, 1, 1); PG8_STAGE(PG8_SA(1, 0), a3, voffA);
            PG8_BAR; PG8_WAIT_L(0); PG8_MMA(1, 0, At, B0); PG8_BAR; PG8_SCHED;
            PG8_STAGE(PG8_SB(1, 1), b3 + hstep, voffB);
            PG8_WAIT_V(6); PG8_BAR; PG8_MMA(1, 1, At, B1); PG8_BAR;
            }
        }
        if constexpr (ALIGN_EPI) { if (wr == 0) PG8_BAR; }
        if constexpr (!Epi::AFTER_DRAIN) { E(acc, cur, wr, wc, fr, fq); S.done(cur); }
        if (!has_next) break;
#pragma unroll
        for (int a = 0; a < 2; ++a)
#pragma unroll
            for (int b = 0; b < 2; ++b)
#pragma unroll
                for (int m = 0; m < 4; ++m)
#pragma unroll
                    for (int n = 0; n < 2; ++n) acc[a][b][m][n] = (f32x4){0.f, 0.f, 0.f, 0.f};
        cur = nxt; cA = nA; cB = nB; ++ui;
        if constexpr (ALIGN_EPI) { if (wr == 1) PG8_BAR; }
    }
    PG8_WAIT_V(0);
    if constexpr (!ALIGN_EPI) { if (wr == 0) PG8_BAR; }
    PG8_BAR;
    if constexpr (Epi::AFTER_DRAIN) { E.fused(acc, cur, wr, wc, fr, fq, lds, wid, lane); S.done(cur); }
#undef PG8_SA
#undef PG8_SB
#undef PG8_STAGE
#undef PG8_LDA
#undef PG8_LDB
#undef PG8_MMA
#undef PG8_WAIT_V
#undef PG8_WAIT_L
#undef PG8_BAR
#undef PG8_SCHED
}
}
namespace attn_body {
using bf16=__hip_bfloat16;
using bf16x8=__attribute__((ext_vector_type(8)))short;
using s16x4=__attribute__((ext_vector_type(4)))short;
using f32x16=__attribute__((ext_vector_type(16)))float;
using u32x4=__attribute__((ext_vector_type(4)))unsigned;
constexpr int BATCH=2,NHEAD=16,SEQ=4096,D=64,DM=NHEAD*D;
constexpr int NW=8,QBLK=32,QB=QBLK*NW,KVBLK=64,NQB=SEQ/QB;
constexpr int ATTN_PITCH=DM, ATTN_UNIT_ROWS=QB;
__device__ __forceinline__ int crow(int r,int hi){return (r&3)+8*(r>>2)+4*hi;}
#define SBAR() __builtin_amdgcn_sched_barrier(0)
__device__ __forceinline__ void cmask(f32x16&p0,f32x16&p1,int jb,int qrel,int hi){
  const float NEG=-INFINITY; int kb=64*jb+4*hi;
  #pragma unroll
  for(int r=0;r<16;++r){int kv=kb+(r&3)+8*(r>>2); if(kv>qrel)p0[r]=NEG; if(kv+32>qrel)p1[r]=NEG;}
}

typedef __attribute__((address_space(3))) const float* lds_cfptr;
__device__ __forceinline__ void bmask(f32x16&p0,f32x16&p1,int t,int qabs,int hi,lds_cfptr lutx){
  const lds_cfptr p=lutx+(qabs-64*t-4*hi+256-59);
  #pragma unroll
  for(int r=0;r<16;++r){ const int k=(r&3)+8*(r>>2); const float a=p[59-k], b=p[59-k-32]; asm volatile("v_add_f32 %0, %0, %1":"+v"(p0[r]):"v"(a)); asm volatile("v_add_f32 %0, %0, %1":"+v"(p1[r]):"v"(b)); }
}
constexpr int NSLOT=3, SLOTB=8192;
constexpr int LDS_K=0, LDS_V=NSLOT*SLOTB, LDS_WS=2*NSLOT*SLOTB, LDS_OST=LDS_WS+NW*64*4, LDS_BYTES=LDS_OST+NW*4096;
constexpr float C2=0.125f*1.4426950408889634f;
__device__ __forceinline__ void glds16(const void*gsrc,unsigned lds_dst){unsigned keep;
  asm volatile("s_mov_b32 %0, m0\n\ts_mov_b32 m0, %2\n\ts_nop 0\n\tglobal_load_lds_dwordx4 %1, off\n\ts_mov_b32 m0, %0":"=&s"(keep):"v"(gsrc),"s"(lds_dst):"memory");}
__device__ __forceinline__ float max3f(float a,float b,float c){float r;asm("v_max3_f32 %0, %1, %2, %3":"=v"(r):"v"(a),"v"(b),"v"(c));return r;}
__device__ __forceinline__ float max2f(float a,float b){float r;asm("v_max_f32_e32 %0, %1, %2":"=v"(r):"v"(a),"v"(b));return r;}
__device__ __forceinline__ float fadd_s(float a,float b){float r;asm("v_add_f32_e32 %0, %1, %2":"=v"(r):"v"(a),"v"(b));return r;}
__device__ __forceinline__ float fsub_s(float a,float b){float r;asm("v_sub_f32_e32 %0, %1, %2":"=v"(r):"v"(a),"v"(b));return r;}
typedef float f32x2_t __attribute__((ext_vector_type(2))); typedef __bf16 bf16x2_t __attribute__((ext_vector_type(2)));
__device__ __forceinline__ unsigned cvtpk_s(float lo,float hi){f32x2_t v={lo,hi};bf16x2_t b=__builtin_convertvector(v,bf16x2_t);return __builtin_bit_cast(unsigned,b);}
#define WAIT_BAR(N) asm volatile("s_waitcnt vmcnt(" #N ") lgkmcnt(0)\n\ts_barrier":::"memory")

__device__ __forceinline__ void qkt(f32x16&p0,f32x16&p1,const char*Kslot,const bf16x8*qr,const f32x16&negm,int r32,int hi){
  const char*kb=Kslot+hi*1024+r32*16;
  #pragma unroll
  for(int d0=0;d0<4;++d0){
    const bf16x8 b0=*reinterpret_cast<const bf16x8*>(kb+d0*2048);
    const bf16x8 b1=*reinterpret_cast<const bf16x8*>(kb+d0*2048+512);
    if(d0==0){p0=__builtin_amdgcn_mfma_f32_32x32x16_bf16(b0,qr[0],negm,0,0,0);p1=__builtin_amdgcn_mfma_f32_32x32x16_bf16(b1,qr[0],negm,0,0,0);}
    else{p0=__builtin_amdgcn_mfma_f32_32x32x16_bf16(b0,qr[d0],p0,0,0,0);p1=__builtin_amdgcn_mfma_f32_32x32x16_bf16(b1,qr[d0],p1,0,0,0);}}
}
typedef __attribute__((address_space(3))) const char* lds_cptr;
typedef short v4i16_t __attribute__((ext_vector_type(4)));
__device__ __forceinline__ void kload8(bf16x8*kf,lds_cptr kp){
  kf[0]=*(const __attribute__((address_space(3))) bf16x8*)(kp);      kf[1]=*(const __attribute__((address_space(3))) bf16x8*)(kp+512);
  kf[2]=*(const __attribute__((address_space(3))) bf16x8*)(kp+2048); kf[3]=*(const __attribute__((address_space(3))) bf16x8*)(kp+2560);
  kf[4]=*(const __attribute__((address_space(3))) bf16x8*)(kp+4096); kf[5]=*(const __attribute__((address_space(3))) bf16x8*)(kp+4608);
  kf[6]=*(const __attribute__((address_space(3))) bf16x8*)(kp+6144); kf[7]=*(const __attribute__((address_space(3))) bf16x8*)(kp+6656);
}
__device__ __forceinline__ void kload2(bf16x8*kf,lds_cptr kp,int j){ kf[2*j]=*(const __attribute__((address_space(3))) bf16x8*)(kp+j*2048); kf[2*j+1]=*(const __attribute__((address_space(3))) bf16x8*)(kp+j*2048+512); }
__device__ __forceinline__ s16x4 vtr(lds_cptr p){ return __builtin_bit_cast(s16x4,__builtin_amdgcn_ds_read_tr16_b64_v4i16((__attribute__((address_space(3))) v4i16_t*)p)); }
__device__ __forceinline__ float rowmax(const f32x16&p0,const f32x16&p1){
  float a=max3f(p0[0],p0[1],p1[0]),b=max3f(p0[2],p0[3],p1[1]);a=max3f(a,p1[2],p1[3]);
  #pragma unroll
  for(int r=4;r<16;r+=4){a=max3f(a,p0[r],p0[r+1]);b=max3f(b,p0[r+2],p0[r+3]);a=max3f(a,p1[r],p1[r+1]);b=max3f(b,p1[r+2],p1[r+3]);}
  const float m=max2f(a,b);
  auto rr=__builtin_amdgcn_permlane32_swap(__float_as_uint(m),__float_as_uint(m),false,false);
  return max2f(__uint_as_float(rr[0]),__uint_as_float(rr[1]));
}
__device__ __forceinline__ void pv(f32x16*o,int vb,bf16x8 pa0,bf16x8 pa1,bf16x8 pa2,bf16x8 pa3){
  #pragma unroll
  for(int d0=0;d0<2;++d0){s16x4 lo[4],hi[4];
    #pragma unroll
    for(int ks=0;ks<4;++ks){
      asm volatile("ds_read_b64_tr_b16 %0,%1 offset:%c2":"=&v"(lo[ks]):"v"(vb),"i"(d0*4096+ks*1024):"memory");
      asm volatile("ds_read_b64_tr_b16 %0,%1 offset:%c2":"=&v"(hi[ks]):"v"(vb),"i"(d0*4096+ks*1024+512):"memory");}
    asm volatile("s_waitcnt lgkmcnt(0)":::"memory");SBAR();
    #define PK(k) (bf16x8){lo[k][0],lo[k][1],lo[k][2],lo[k][3],hi[k][0],hi[k][1],hi[k][2],hi[k][3]}
    o[d0]=__builtin_amdgcn_mfma_f32_32x32x16_bf16(pa0,PK(0),o[d0],0,0,0);
    o[d0]=__builtin_amdgcn_mfma_f32_32x32x16_bf16(pa1,PK(1),o[d0],0,0,0);
    o[d0]=__builtin_amdgcn_mfma_f32_32x32x16_bf16(pa2,PK(2),o[d0],0,0,0);
    o[d0]=__builtin_amdgcn_mfma_f32_32x32x16_bf16(pa3,PK(3),o[d0],0,0,0);
    #undef PK
  }
}

#ifndef ATTN_STORE16
#define ATTN_STORE16(p,v) (*(u32x4*)(p)=(v))
#endif
template<int THRL> __device__ __forceinline__ void attn_unit(int b,int hq,int hv,int qb,const bf16*Q,const bf16*__restrict__ K,const bf16*__restrict__ V,bf16*O,char*shm,lds_cfptr lut){
  int tid_o=threadIdx.x; asm volatile("":"+v"(tid_o)); const int tid=tid_o,lane=tid&63,r32=lane&31,hi=lane>>5; const int wid=__builtin_amdgcn_readfirstlane(tid>>6);
  const long rowbase=(long)b*SEQ; const int q0=qb*QB;
  const bf16*Qw=Q+(rowbase+q0+wid*QBLK)*DM+hq*D;
  const bf16*Kh=K+rowbase*DM+hq*D,*Vh=V+rowbase*DM+hv*D;
  const unsigned lds0=(unsigned)(uintptr_t)shm;
  float*wsf=(float*)(shm+LDS_WS)+wid*64;
  const bf16*ksrc=Kh+(long)lane*DM+wid*8;
  const bf16*vsrc=Vh+(long)(16*(wid&3)+(lane>>2))*DM+(wid>>2)*32+(lane&3)*8;
  const unsigned kdst=lds0+LDS_K+wid*1024, vdst=lds0+LDS_V+wid*1024;
  #define DMA_K(t,slot) glds16(ksrc+(long)(t)*KVBLK*DM,(unsigned)__builtin_amdgcn_readfirstlane(kdst+(slot)))
  #define DMA_V(t,slot) glds16(vsrc+(long)(t)*KVBLK*DM,(unsigned)__builtin_amdgcn_readfirstlane(vdst+(slot)))
  const int vb0=(int)(lds0+LDS_V)+((lane>>4)&1)*32+(lane&3)*8+(4*hi+((lane&15)>>2))*64;
  const char*Kbase=shm+LDS_K; bf16x8 kf[8];
  const lds_cptr shm3=(lds_cptr)shm; const lds_cptr kp0=shm3+LDS_K+hi*1024+r32*16; const lds_cptr vp0=shm3+LDS_V+((lane>>4)&1)*32+(lane&3)*8+(4*hi+((lane&15)>>2))*64;
  const int NT=(q0+QB)/KVBLK;
  DMA_K(0,0);DMA_V(0,0);DMA_K(1,SLOTB);
  bf16x8 qr[4];
  #pragma unroll
  for(int d0=0;d0<4;++d0)qr[d0]=*reinterpret_cast<const bf16x8*>(&Qw[(long)r32*DM+d0*16+hi*8]);
  float mhat=0.f,l_reg=0.f;f32x16 o[2];o[0]=f32x16{};o[1]=f32x16{};f32x16 negm=f32x16{};asm volatile("":"+v"(negm));
  const int qrel=wid*QBLK+r32;
  #define CMASK(P0,P1,t) do{ if((t)>=NT-6) bmask(P0,P1,(t),q0+qrel,hi,lut); }while(0)
  bool resc=false;
  #define START(P0,P1) do{ const float rm=rowmax(P0,P1); resc=false; \
    { const float dl=rm; mhat=fadd_s(mhat,dl); \
      _Pragma("unroll") for(int r=0;r<16;++r){P0[r]=fsub_s(P0[r],dl);P1[r]=fsub_s(P1[r],dl);} \
      _Pragma("unroll") for(int r=0;r<16;++r)negm[r]=-mhat; asm volatile("":"+v"(negm)); } \
    _Pragma("unroll") for(int r=0;r<16;++r)P0[r]=__builtin_amdgcn_exp2f(P0[r]); }while(0)
  #define RESC() do{ if(resc){ asm volatile("s_waitcnt lgkmcnt(0)":::"memory"); \
      _Pragma("unroll") for(int d_=0;d_<2;++d_) _Pragma("unroll") for(int r=0;r<16;++r)o[d_][r]*=wsf[crow(r,hi)]; } }while(0)
  f32x16 pA0,pA1,pB0,pB1;
  int sl_prev=0,sl_cur=0,sl_next=SLOTB;
  #define ROT() do{sl_prev=sl_cur;sl_cur=sl_next;sl_next=(sl_next==(NSLOT-1)*SLOTB)?0:sl_next+SLOTB;}while(0)
  DMA_K(2,2*SLOTB);
  WAIT_BAR(3);
  qkt(pA0,pA1,Kbase,qr,negm,r32,hi);asm volatile("s_nop 15\n\ts_nop 7":"+v"(pA0),"+v"(pA1));CMASK(pA0,pA1,0);
  START(pA0,pA1);
  _Pragma("unroll") for(int r=0;r<16;++r)pA1[r]=__builtin_amdgcn_exp2f(pA1[r]);
  WAIT_BAR(0);
  DMA_K(3,0);DMA_V(1,SLOTB);
  ROT();
  kload8(kf,kp0+sl_cur);
  WAIT_BAR(2);
  s16x4 vlo[8],vhi[8]; u32x4 pw0,pw1,pw2,pw3;
  #define PKW(P,B) cvtpk_s(P[B],P[B+1])
  #define PAF(k) __builtin_bit_cast(bf16x8,pw##k)
  #define VFR(i) (bf16x8){vlo[i][0],vlo[i][1],vlo[i][2],vlo[i][3],vhi[i][0],vhi[i][1],vhi[i][2],vhi[i][3]}
  #define PIN(x) asm volatile("":"+v"(x))
  #define MX3(a,b,c) __builtin_fmaxf(__builtin_fmaxf((a),(b)),(c))
  #define GAPA(MF,A0,A1,A2,A3,W0,W1,PW) do{ MF; sacc+=A0; sacc+=A1; sacc+=A2; sacc+=A3; PIN(sacc); W0; W1; PIN(PW); SBAR(); }while(0)
  #define EX(v) __builtin_amdgcn_exp2f(v)
  #define GAPB(MF,X,B) do{ MF; X[B]=EX(X[B]); X[B+1]=EX(X[B+1]); X[B+2]=EX(X[B+2]); X[B+3]=EX(X[B+3]); PIN(X); SBAR(); }while(0)
  #define VRD(i) do{ vlo[i]=vtr(vp_+(((i)>>2)*4096+((i)&3)*1024)); vhi[i]=vtr(vp_+(((i)>>2)*4096+((i)&3)*1024+512)); }while(0)
  #define KRD(G,j) do{ if(G){ kload2(kf,kp0+sl_next,j); SBAR(); } }while(0)
  #define STEP(C0,C1,P0,P1,t,GK,GV,GL) do{ SBAR(); \
    const lds_cptr vp_=vp0+sl_prev; \
    VRD(0); SBAR(); float sacc=(P0[0]+P0[1]); \
    GAPA(C0=__builtin_amdgcn_mfma_f32_32x32x16_bf16(kf[0],qr[0],negm,0,0,0), P0[2],P0[3],P0[4],P0[5],     pw0[0]=PKW(P0,0), pw0[1]=PKW(P0,2), pw0); \
    VRD(4); SBAR(); GAPA(C1=__builtin_amdgcn_mfma_f32_32x32x16_bf16(kf[1],qr[0],negm,0,0,0), P0[6],P0[7],P0[8],P0[9],     pw0[2]=PKW(P0,4), pw0[3]=PKW(P0,6), pw0); \
    VRD(1); SBAR(); GAPA(C0=__builtin_amdgcn_mfma_f32_32x32x16_bf16(kf[2],qr[1],C0,0,0,0),   P0[10],P0[11],P0[12],P0[13], pw1[0]=PKW(P0,8), pw1[1]=PKW(P0,10), pw1); \
    VRD(5); SBAR(); GAPA(C1=__builtin_amdgcn_mfma_f32_32x32x16_bf16(kf[3],qr[1],C1,0,0,0),   P0[14],P0[15],P1[0],P1[1],   pw1[2]=PKW(P0,12),pw1[3]=PKW(P0,14), pw1); \
    VRD(2); SBAR(); GAPA(C0=__builtin_amdgcn_mfma_f32_32x32x16_bf16(kf[4],qr[2],C0,0,0,0),   P1[2],P1[3],P1[4],P1[5],     pw2[0]=PKW(P1,0), pw2[1]=PKW(P1,2), pw2); \
    VRD(6); SBAR(); GAPA(C1=__builtin_amdgcn_mfma_f32_32x32x16_bf16(kf[5],qr[2],C1,0,0,0),   P1[6],P1[7],P1[8],P1[9],     pw2[2]=PKW(P1,4), pw2[3]=PKW(P1,6), pw2); \
    VRD(3); SBAR(); GAPA(C0=__builtin_amdgcn_mfma_f32_32x32x16_bf16(kf[6],qr[3],C0,0,0,0),   P1[10],P1[11],P1[12],P1[13], pw3[0]=PKW(P1,8), pw3[1]=PKW(P1,10), pw3); \
    VRD(7); SBAR(); GAPA(C1=__builtin_amdgcn_mfma_f32_32x32x16_bf16(kf[7],qr[3],C1,0,0,0),   P1[14],P1[15],0.f,0.f,       pw3[2]=PKW(P1,12),pw3[3]=PKW(P1,14), pw3); \
    asm volatile("s_nop 15\n\ts_nop 7":"+v"(C0),"+v"(C1));   \
    l_reg+=sacc; \
    if(GK){DMA_K((t)+3,sl_cur);} if(GV){DMA_V((t)+1,sl_next);} \
    CMASK(C0,C1,t); \
    { float a=MX3(C0[0],C0[1],C1[0]),b=MX3(C0[2],C0[3],C1[1]); a=MX3(a,C1[2],C1[3]); \
      _Pragma("unroll") for(int r=4;r<16;r+=4){a=MX3(a,C0[r],C0[r+1]);b=MX3(b,C0[r+2],C0[r+3]);a=MX3(a,C1[r],C1[r+1]);b=MX3(b,C1[r+2],C1[r+3]);} \
      float rm=__builtin_fmaxf(a,b); { auto rr=__builtin_amdgcn_permlane32_swap(__float_as_uint(rm),__float_as_uint(rm),false,false); rm=__builtin_fmaxf(__uint_as_float(rr[0]),__uint_as_float(rr[1])); } \
      resc=false; \
      if(__builtin_expect(__any(rm>(float)THRL),0)){ const float dl=__builtin_fmaxf(rm,0.f); mhat+=dl; \
        _Pragma("unroll") for(int r=0;r<16;++r){C0[r]-=dl;C1[r]-=dl;} \
        _Pragma("unroll") for(int r=0;r<16;++r)negm[r]=-mhat; asm volatile("":"+v"(negm)); \
        const float f=__builtin_amdgcn_exp2f(-dl); l_reg*=f; if(hi==0)wsf[r32]=f; resc=true; } } \
    SBAR(); \
    GAPB(o[0]=__builtin_amdgcn_mfma_f32_32x32x16_bf16(PAF(0),VFR(0),o[0],0,0,0), C0,0); \
    GAPB(o[1]=__builtin_amdgcn_mfma_f32_32x32x16_bf16(PAF(0),VFR(4),o[1],0,0,0), C0,4); \
    KRD(GL,0); GAPB(o[0]=__builtin_amdgcn_mfma_f32_32x32x16_bf16(PAF(1),VFR(1),o[0],0,0,0), C0,8); \
    KRD(GL,1); GAPB(o[1]=__builtin_amdgcn_mfma_f32_32x32x16_bf16(PAF(1),VFR(5),o[1],0,0,0), C0,12); \
    KRD(GL,2); GAPB(o[0]=__builtin_amdgcn_mfma_f32_32x32x16_bf16(PAF(2),VFR(2),o[0],0,0,0), C1,0); \
    KRD(GL,3); GAPB(o[1]=__builtin_amdgcn_mfma_f32_32x32x16_bf16(PAF(2),VFR(6),o[1],0,0,0), C1,4); \
    GAPB(o[0]=__builtin_amdgcn_mfma_f32_32x32x16_bf16(PAF(3),VFR(3),o[0],0,0,0), C1,8); \
    GAPB(o[1]=__builtin_amdgcn_mfma_f32_32x32x16_bf16(PAF(3),VFR(7),o[1],0,0,0), C1,12); \
    }while(0)
  int t=1;
  #undef CMASK
  #define CMASK(P0,P1,t) do{}while(0)
  for(;t+7<NT;t+=2){
    STEP(pB0,pB1,pA0,pA1,t,true,true,true);     WAIT_BAR(2); RESC(); ROT();
    STEP(pA0,pA1,pB0,pB1,t+1,true,true,true);   WAIT_BAR(2); RESC(); ROT();
  }
  #undef CMASK
  #define CMASK(P0,P1,t) do{ if((t)>=NT-6) bmask(P0,P1,(t),q0+qrel,hi,lut); }while(0)
  #define ENDW(tt) do{ if((tt)+3<NT){WAIT_BAR(2);} else if((tt)+2<NT){WAIT_BAR(1);} else {WAIT_BAR(0);} }while(0)
  for(;t+1<NT;t+=2){
    STEP(pB0,pB1,pA0,pA1,t,(t+3<NT),(t+1<NT),(t+1<NT));       ENDW(t);   RESC(); ROT();
    STEP(pA0,pA1,pB0,pB1,t+1,(t+4<NT),(t+2<NT),(t+2<NT));     ENDW(t+1); RESC(); ROT();
  }
  STEP(pB0,pB1,pA0,pA1,NT-1,false,false,false); RESC();
  { float sacc=pB0[0]+pB0[1]; _Pragma("unroll") for(int r=2;r<16;++r)sacc+=pB0[r]; _Pragma("unroll") for(int r=0;r<16;++r)sacc+=pB1[r]; l_reg+=sacc;
    pw0=(u32x4){PKW(pB0,0),PKW(pB0,2),PKW(pB0,4),PKW(pB0,6)};pw1=(u32x4){PKW(pB0,8),PKW(pB0,10),PKW(pB0,12),PKW(pB0,14)};pw2=(u32x4){PKW(pB1,0),PKW(pB1,2),PKW(pB1,4),PKW(pB1,6)};pw3=(u32x4){PKW(pB1,8),PKW(pB1,10),PKW(pB1,12),PKW(pB1,14)};
    SBAR(); pv(o,vb0+sl_cur,PAF(0),PAF(1),PAF(2),PAF(3)); }
  #undef PKW
  #undef PAF
  #undef VFR
  #undef PIN
  #undef MX3
  #undef GAPA
  #undef GAPB
  #undef EX
  #undef VRD
  #undef KRD
  #undef STEP
  #undef ENDW
  {auto rr=__builtin_amdgcn_permlane32_swap(__float_as_uint(l_reg),__float_as_uint(l_reg),false,false);l_reg=__uint_as_float(rr[0])+__uint_as_float(rr[1]);}
  if(hi==0)wsf[32+r32]=l_reg;asm volatile("s_waitcnt lgkmcnt(0)":::"memory");
  float rli[16];
  #pragma unroll
  for(int r=0;r<16;++r)rli[r]=__builtin_amdgcn_rcpf(wsf[32+crow(r,hi)]);
  bf16*Ow=O+(rowbase+q0+wid*QBLK)*DM+hv*D;
  { bf16*stg=(bf16*)(shm+LDS_OST)+wid*2048;
    #pragma unroll
    for(int r=0;r<16;++r){const int orow=crow(r,hi);
      #pragma unroll
      for(int d0=0;d0<2;++d0)stg[orow*64+d0*32+r32]=__float2bfloat16(o[d0][r]*rli[r]);}
    asm volatile("s_waitcnt lgkmcnt(0)":::"memory");
    #pragma unroll
    for(int i=0;i<4;++i){const int row=i*8+(lane>>3),ch=lane&7; const u32x4 v=*(const u32x4*)(stg+row*64+ch*8); ATTN_STORE16(Ow+(long)row*DM+ch*8,v);} }
  asm volatile("s_waitcnt lgkmcnt(0)\n\ts_barrier":::"memory");
  #undef DMA_K
  #undef DMA_V
  #undef CMASK
  #undef START
  #undef RESC
  #undef ROT
}
constexpr int ATTN_LDS_BYTES=LDS_BYTES;

#undef SBAR
#undef WAIT_BAR
}
#define GAS __attribute__((address_space(1)))
#define LAS __attribute__((address_space(3)))
typedef unsigned short bf16;
typedef unsigned v4u __attribute__((ext_vector_type(4)));
typedef float f32x4 __attribute__((ext_vector_type(4)));
typedef short bf16x8 __attribute__((ext_vector_type(8)));
typedef GAS unsigned gu32;
typedef GAS unsigned long long gu64;
#define RLX_AGENT __ATOMIC_RELAXED, __HIP_MEMORY_SCOPE_AGENT
#define LDS_WAIT() asm volatile("s_waitcnt lgkmcnt(0)" ::: "memory")
#define VM_WAIT() asm volatile("s_waitcnt vmcnt(0)" ::: "memory")
__device__ __forceinline__ unsigned long long rt() { return __builtin_amdgcn_s_memrealtime(); }
__device__ __forceinline__ unsigned f2bf(float f) { unsigned u = __builtin_bit_cast(unsigned, f); return (u + 0x7fffu + ((u >> 16) & 1u)) >> 16; }
__device__ __forceinline__ unsigned pk2(float lo, float hi) { return f2bf(lo) | (f2bf(hi) << 16); }

#define XB_TMO      128
#define XB_XCNT(j)  (256  + 64 * (j))
#define XB_XSUB(j)  (1280 + 64 * (j))
#define XB_XGEN(j)  (2304 + 64 * (j))
#define XB_TOP      3328
#define XB_TOPGEN   3392
#define XCD_BAR_WORDS 3456
#define XB_SPIN_CAP (1u << 18)

__device__ __forceinline__ unsigned xb_ld(unsigned* p)              { return __hip_atomic_load(p, __ATOMIC_RELAXED, __HIP_MEMORY_SCOPE_AGENT); }
__device__ __forceinline__ unsigned xb_add(unsigned* p, unsigned v) { return __hip_atomic_fetch_add(p, v, __ATOMIC_RELAXED, __HIP_MEMORY_SCOPE_AGENT); }
__device__ __forceinline__ unsigned xb_xcc_id() { return (unsigned)__builtin_amdgcn_s_getreg((3 << 11) | 20) & 0xFu; }
#define XB_SPIN(cond, bar) do { unsigned _sp = 0; while (cond) { __builtin_amdgcn_s_sleep(1); \
    if ((++_sp & 255u) == 0u) { if (xb_ld(&(bar)[XB_TMO])) break; if (_sp > XB_SPIN_CAP) { atomicAdd(&(bar)[XB_TMO], 1u); break; } } } } while (0)

struct XcdBarrier {
    unsigned* bar; unsigned x;
    volatile LAS unsigned* st;
};

__device__ __forceinline__ XcdBarrier xcd_barrier_post(unsigned* bar, volatile LAS unsigned* st) {
    XcdBarrier b; b.bar = bar; b.x = xb_xcc_id(); b.st = st;
    if (threadIdx.x == 0) (void)xb_add(&bar[XB_XCNT(b.x)], 1u);
    return b;
}
__device__ __forceinline__ void xcd_barrier_complete(unsigned* bar, unsigned x, unsigned& nloc, unsigned& nx) {
    const unsigned G = gridDim.x * gridDim.y * gridDim.z;
    unsigned sum, cnt, mine, sp = 0u;
    for (;;) {
        sum = 0u; cnt = 0u; mine = 0u;
#pragma unroll
        for (unsigned j = 0; j < 16; ++j) { const unsigned c = xb_ld(&bar[XB_XCNT(j)]); sum += c; cnt += (c > 0u) ? 1u : 0u; mine = (j == x) ? c : mine; }
        if (sum == G) break;
        __builtin_amdgcn_s_sleep(1);
        if ((++sp & 255u) == 0u) { if (xb_ld(&bar[XB_TMO])) break; if (sp > XB_SPIN_CAP) { atomicAdd(&bar[XB_TMO], 1u); break; } }
    }
    nloc = mine > 0u ? mine : 1u; nx = cnt > 0u ? cnt : 1u;
}

__device__ __forceinline__ void xcd_barrier(const XcdBarrier& b) {
    asm volatile("s_waitcnt vmcnt(0)" ::: "memory");
    __syncthreads();
    if (threadIdx.x == 0) {
        unsigned* bar = b.bar;
        __builtin_amdgcn_s_waitcnt(0);
        unsigned nloc = b.st[0], nx = b.st[1];
        if (nloc == 0u) { xcd_barrier_complete(bar, b.x, nloc, nx); b.st[0] = nloc; b.st[1] = nx; }
        const unsigned old = xb_add(&bar[XB_XSUB(b.x)], 1u);
        const unsigned gen = old / nloc;
        if (old + 1u == (gen + 1u) * nloc) {
            __builtin_amdgcn_fence(__ATOMIC_RELEASE, "agent");
            asm volatile("s_waitcnt vmcnt(0)" ::: "memory");
            const unsigned og = xb_add(&bar[XB_TOP], 1u);
            const unsigned tg = og / nx;
            if (og + 1u == (tg + 1u) * nx) xb_add(&bar[XB_TOPGEN], 1u);
            else XB_SPIN(xb_ld(&bar[XB_TOPGEN]) == tg, bar);
            __builtin_amdgcn_fence(__ATOMIC_ACQUIRE, "agent");
            xb_add(&bar[XB_XGEN(b.x)], 1u);
            asm volatile("s_waitcnt vmcnt(0)" ::: "memory");
        } else {
            XB_SPIN(xb_ld(&bar[XB_XGEN(b.x)]) == gen, bar);
            __builtin_amdgcn_fence(__ATOMIC_ACQUIRE, "agent");
            asm volatile("s_waitcnt vmcnt(0)" ::: "memory");
        }
    }
    __syncthreads();
}

constexpr int NWAVES = 8, NTHR = 512;
constexpr int DMODEL = 2048, TP = 8192, SEQL = 4096, TSM = 32, DECB = 8, DECS = 4;
constexpr int ATTW = 1024, DIN = 4096, DFF = 5504, PLED = 256, NPAGE = 128, PAGESZ = 128, PASTLEN = 16384;
constexpr float C2F = 0.125f * 1.4426950408889634f, LOG2E = 1.4426950408889634f, NEPS = 1e-6f, SUBLN_EPS = 1e-5f, LAM_INIT = 0.2f;
enum { I_XP = 0, I_XS, I_CK, I_CV, I_SRE, I_SIM, I_SCONV, I_PT, I_PP, I_PS, I_RELB, I_NMIXG, I_WIN, I_LQ1, I_LK1, I_LQ2, I_LK2, I_SUBLNG, I_ARE, I_AIM, I_BRE, I_BIM, I_CRE, I_CIM, I_SD,
       I_LOGDT, I_GLUW, I_GLUB, I_SOUTG, I_WOUT, I_NFFNG, I_WUP, I_CONVW, I_CONVB, I_WDN, I_NPLEG, I_WPG, I_WPP, I_NFING, N_IN };
constexpr size_t O_YP = 0, O_YS = O_YP + (size_t)TP * DMODEL, O_KP = O_YS + (size_t)TSM * DMODEL, O_VP = O_KP + (size_t)TP * ATTW, O_SREP = O_VP + (size_t)TP * ATTW,
                 O_SIMP = O_SREP + 2 * 64 * 64, O_CONVP = O_SIMP + 2 * 64 * 64, O_KS = O_CONVP + 2 * 2 * DFF, O_VS = O_KS + (size_t)TSM * ATTW, O_SRES = O_VS + (size_t)TSM * ATTW,
                 O_SIMS = O_SRES + 8 * 64 * 64, O_CONVS = O_SIMS + 8 * 64 * 64, O_END = O_CONVS + 8 * 2 * DFF;
constexpr size_t al256(size_t x) { return (x + 255) & ~(size_t)255; }
constexpr size_t WS_CTL = 0, CTL_ZERO_BYTES = 1u << 20;
constexpr int CW_BAR = 4096;
constexpr size_t WS_WIN = CTL_ZERO_BYTES;
constexpr size_t WS_WOUT = WS_WIN + (size_t)DIN * DMODEL * 2;
constexpr size_t WS_WUP = WS_WOUT + (size_t)DMODEL * DMODEL * 2;
constexpr size_t WS_WDN = WS_WUP + (size_t)2 * DFF * DMODEL * 2;
constexpr size_t WS_WPG = WS_WDN + (size_t)DMODEL * DFF * 2;
constexpr size_t WS_WPP = WS_WPG + (size_t)DMODEL * DMODEL * 2;
constexpr size_t WS_XB = WS_WPP + (size_t)DMODEL * PLED * 2;
constexpr size_t WS_RSX = WS_XB + (size_t)TP * DMODEL * 2;
constexpr size_t WS_PB = WS_RSX + al256((TP + TSM) * 4);
constexpr size_t WS_QB = WS_PB + (size_t)TP * PLED * 2;
constexpr size_t WS_KB = WS_QB + (size_t)TP * ATTW * 2;
constexpr size_t WS_VB = WS_KB + (size_t)TP * ATTW * 2;
constexpr size_t WS_US = WS_VB + (size_t)TP * ATTW * 2;
constexpr size_t WS_O1 = WS_US + (size_t)TP * ATTW * 4;
constexpr size_t WS_O2 = WS_O1 + (size_t)TP * ATTW * 2;
constexpr size_t WS_GS = WS_O2 + (size_t)TP * ATTW * 2;
constexpr size_t WS_OA = WS_GS + (size_t)TP * ATTW * 2;
constexpr size_t WS_H1 = WS_OA + (size_t)TP * DMODEL * 2;
constexpr size_t WS_H1B = WS_H1 + (size_t)TP * DMODEL * 4;
constexpr size_t WS_SS1 = WS_H1B + (size_t)TP * DMODEL * 2;
constexpr size_t WS_G = WS_SS1 + (size_t)TP * 8 * 4;
constexpr size_t WS_V2 = WS_G + (size_t)TP * DFF * 2;
constexpr size_t WS_HFF = WS_V2 + (size_t)TP * DFF * 2;
constexpr size_t WS_H2 = WS_HFF + (size_t)TP * DFF * 2;
constexpr size_t WS_H2B = WS_H2 + (size_t)TP * DMODEL * 4;
constexpr size_t WS_SS2 = WS_H2B + (size_t)TP * DMODEL * 2;
constexpr size_t WS_PROJ = WS_SS2 + (size_t)TP * 8 * 4;
constexpr size_t WS_SS3 = WS_PROJ + (size_t)TP * DMODEL * 2;
constexpr size_t WS_AB = WS_SS3 + (size_t)TP * 8 * 4;
constexpr size_t WS_BBR = WS_AB + 64 * 64 * 2 * 4;
constexpr size_t WS_BBI = WS_BBR + 64 * 64 * 16 * 4;
constexpr size_t WS_LUT = WS_BBI + 64 * 64 * 16 * 4;
constexpr size_t WS_LAM = WS_LUT + al256(8 * 130 * 4);
constexpr size_t WS_XSB = WS_LAM + 256;
constexpr size_t WS_PSB = WS_XSB + (size_t)TSM * DMODEL * 2;
constexpr size_t WS_QS = WS_PSB + (size_t)TSM * PLED * 2;
constexpr size_t WS_USS = WS_QS + (size_t)TSM * ATTW * 4;
constexpr size_t WS_PROJS = WS_USS + (size_t)TSM * ATTW * 4;
constexpr size_t WS_GSS = WS_PROJS + (size_t)TSM * DMODEL * 4;
constexpr size_t WS_OAS = WS_GSS + (size_t)TSM * ATTW * 2;
constexpr size_t WS_H1S = WS_OAS + (size_t)TSM * DMODEL * 2;
constexpr size_t WS_H1SB = WS_H1S + (size_t)TSM * DMODEL * 4;
constexpr size_t WS_SS1S = WS_H1SB + (size_t)TSM * DMODEL * 2;
constexpr size_t WS_GUS = WS_SS1S + (size_t)TSM * 128 * 4;
constexpr size_t WS_VUS = WS_GUS + al256((size_t)TSM * DFF * 4);
constexpr size_t WS_HFFS = WS_VUS + al256((size_t)TSM * DFF * 4);
constexpr size_t WS_H2S = WS_HFFS + al256((size_t)TSM * DFF * 2);
constexpr size_t WS_H2SB = WS_H2S + (size_t)TSM * DMODEL * 4;
constexpr size_t WS_SS2S = WS_H2SB + (size_t)TSM * DMODEL * 2;
constexpr size_t WS_SS3S = WS_SS2S + (size_t)TSM * 128 * 4;
constexpr size_t WS_PART = WS_SS3S + (size_t)TSM * 128 * 4;
constexpr size_t WS_GF = WS_PART + al256((size_t)256 * 8 * 130 * 4);
constexpr size_t WS_VF = WS_GF + al256((size_t)64 * DFF * 4);
constexpr size_t WS_GL = WS_VF + al256((size_t)64 * DFF * 4);
constexpr size_t WS_END = WS_GL + al256((size_t)64 * DFF * 4);
constexpr int RING_OFF = 0, RING_BYTES = 131072;
constexpr int LDSCTL_OFF = RING_BYTES, MISC_OFF = LDSCTL_OFF + 320;
constexpr int LUT_OFF = RING_BYTES + 1024;
constexpr int RS_OFF = LUT_OFF + 4352;
constexpr int HAL_OFF = RS_OFF + 256;
constexpr int LUTX_OFF = 90112;
constexpr int LDS_BYTES = 147456;
static_assert(HAL_OFF + 4096 <= LDS_BYTES && HAL_OFF % 16 == 0, "LDS map");

struct Args { const float* in[N_IN]; float* out; unsigned char* ws; };

__device__ __forceinline__ float wave_sum(float v) {
#pragma unroll
    for (int o = 1; o < 64; o <<= 1) v += __shfl_xor(v, o);
    return v;
}
__device__ __forceinline__ float bflo(unsigned w) { return __uint_as_float(w << 16); }
__device__ __forceinline__ float bfhi(unsigned w) { return __uint_as_float(w & 0xffff0000u); }
__device__ __forceinline__ float sigmoidf_(float x) { return __builtin_amdgcn_rcpf(1.f + __builtin_amdgcn_exp2f(-LOG2E * x)); }
__device__ __forceinline__ float gelu_tanh(float x) { const float z = 0.7978845608028654f * (x + 0.044715f * x * x * x); return x * __builtin_amdgcn_rcpf(1.f + __builtin_amdgcn_exp2f(-2.f * LOG2E * z)); }
#define MFMA_SETTLE(x) asm volatile("s_nop 15\n\ts_nop 15" : "+v"(x))
#define WG_SYNC() do { asm volatile("s_waitcnt vmcnt(0) lgkmcnt(0)" ::: "memory"); __builtin_amdgcn_s_barrier(); asm volatile("" ::: "memory"); } while (0)

__device__ __forceinline__ void p0_transpose_item(const float* W, int K, int N, const float* gain, bf16* WT, int upmode, LAS float* scr, int item, int lane) {
    const int nblk = N / 32, kb = item / nblk, nb = item % nblk, k0 = 64 * kb, n0 = 32 * nb;
#pragma unroll 8
    for (int i = 0; i < 32; ++i) { const int kk = 2 * i + (lane >> 5); const float g = gain ? gain[k0 + kk] : 1.f; scr[kk * 33 + (lane & 31)] = W[(size_t)(k0 + kk) * N + n0 + (lane & 31)] * g; }
    LDS_WAIT(); asm volatile("" ::: "memory");
    int drow0 = n0;
    if (upmode) { const int isv = n0 >= DFF, j = isv ? n0 - DFF : n0; drow0 = 256 * (j >> 7) + (isv ? 128 : 0) + (j & 127); }
    const int c = lane & 7;
#pragma unroll
    for (int j = 0; j < 4; ++j) { const int n = (lane >> 3) + 8 * j; const LAS float* s = scr + (8 * c) * 33 + n;
        v4u o; o.x = pk2(s[0 * 33], s[1 * 33]); o.y = pk2(s[2 * 33], s[3 * 33]); o.z = pk2(s[4 * 33], s[5 * 33]); o.w = pk2(s[6 * 33], s[7 * 33]);
        *(GAS v4u*)(WT + (size_t)(drow0 + n) * K + k0 + 8 * c) = o; }
    LDS_WAIT(); asm volatile("" ::: "memory");
}
__device__ __forceinline__ void p0_row2048(const float* xrow, bf16* orow, float* rstd_out, int lane) {
    const GAS f32x4* xr = (const GAS f32x4*)xrow + lane; f32x4 v[8]; float s = 0.f;
#pragma unroll
    for (int j = 0; j < 8; ++j) { v[j] = xr[64 * j]; s += (v[j].x * v[j].x + v[j].y * v[j].y) + (v[j].z * v[j].z + v[j].w * v[j].w); }
    s = wave_sum(s);
    if (lane == 0) *rstd_out = 1.0f / sqrtf(s * (1.0f / 2048.0f) + NEPS);
    GAS unsigned long long* o8 = (GAS unsigned long long*)orow + lane;
#pragma unroll
    for (int j = 0; j < 8; ++j) o8[64 * j] = (unsigned long long)pk2(v[j].x, v[j].y) | ((unsigned long long)pk2(v[j].z, v[j].w) << 32);
}
__device__ __forceinline__ int t5_bucket(int n) {
    if (n < 16) return n;
    int b = 16 + (int)(logf((float)n / 16.0f) / 2.0794415416798357f * 16.0f);
    return b > 31 ? 31 : b;
}
__device__ __forceinline__ void p0_prologue(const Args& A, LAS unsigned char* lds, int vcu, int G, int wave, int lane) {
    unsigned char* ws = A.ws;
    LAS float* scr = (LAS float*)(lds + RING_OFF + wave * 16384);
    const int gw = vcu * NWAVES + wave, NGW = G * NWAVES;
    constexpr int I_IN = (DMODEL / 64) * (DIN / 32), I_OUT = (DMODEL / 64) * (DMODEL / 32), I_UP = (DMODEL / 64) * (2 * DFF / 32), I_DN = (DFF / 64) * (DMODEL / 32), I_PG = I_OUT, I_PPJ = (PLED / 64) * (DMODEL / 32);
    constexpr int NITEMS = I_IN + I_OUT + I_UP + I_DN + I_PG + I_PPJ;
    for (int it = gw; it < NITEMS; it += NGW) {
        int r = it;
        if (r < I_IN) { p0_transpose_item(A.in[I_WIN], DMODEL, DIN, A.in[I_NMIXG], (bf16*)(ws + WS_WIN), 0, scr, r, lane); continue; } r -= I_IN;
        if (r < I_OUT) { p0_transpose_item(A.in[I_WOUT], DMODEL, DMODEL, nullptr, (bf16*)(ws + WS_WOUT), 0, scr, r, lane); continue; } r -= I_OUT;
        if (r < I_UP) { p0_transpose_item(A.in[I_WUP], DMODEL, 2 * DFF, A.in[I_NFFNG], (bf16*)(ws + WS_WUP), 1, scr, r, lane); continue; } r -= I_UP;
        if (r < I_DN) { p0_transpose_item(A.in[I_WDN], DFF, DMODEL, nullptr, (bf16*)(ws + WS_WDN), 0, scr, r, lane); continue; } r -= I_DN;
        if (r < I_PG) { p0_transpose_item(A.in[I_WPG], DMODEL, DMODEL, A.in[I_NPLEG], (bf16*)(ws + WS_WPG), 0, scr, r, lane); continue; } r -= I_PG;
        p0_transpose_item(A.in[I_WPP], PLED, DMODEL, nullptr, (bf16*)(ws + WS_WPP), 0, scr, r, lane);
    }
    for (int m = gw; m < TP + TSM; m += NGW) {
        if (m < TP) p0_row2048(A.in[I_XP] + (size_t)m * DMODEL, (bf16*)(ws + WS_XB) + (size_t)m * DMODEL, (float*)(ws + WS_RSX) + m, lane);
        else p0_row2048(A.in[I_XS] + (size_t)(m - TP) * DMODEL, (bf16*)(ws + WS_XSB) + (size_t)(m - TP) * DMODEL, (float*)(ws + WS_RSX) + m, lane);
    }
    for (int m = gw; m < TP + TSM; m += NGW) {
        const float* src = m < TP ? A.in[I_PP] + (size_t)m * PLED : A.in[I_PS] + (size_t)(m - TP) * PLED;
        bf16* dst = m < TP ? (bf16*)(ws + WS_PB) + (size_t)m * PLED : (bf16*)(ws + WS_PSB) + (size_t)(m - TP) * PLED;
        const f32x4 v = ((const GAS f32x4*)src)[lane];
        ((GAS unsigned long long*)dst)[lane] = (unsigned long long)pk2(v.x, v.y) | ((unsigned long long)pk2(v.z, v.w) << 32);
    }
    const int gt = gw * 64 + lane;
    if (gt < 64 * 64) {
        const int g = gt >> 6;
        const float dt = expf(A.in[I_LOGDT][g]), are = A.in[I_ARE][gt], aim = A.in[I_AIM][gt];
        const float decay = expf(are * dt), abr = decay * cosf(aim * dt), abi = decay * sinf(aim * dt);
        const float den = are * are + aim * aim, numr = abr - 1.0f;
        const float cr = (numr * are + abi * aim) / den, ci = (abi * are - numr * aim) / den;
        float* AB = (float*)(ws + WS_AB); AB[gt * 2] = abr; AB[gt * 2 + 1] = abi;
        float* BBR = (float*)(ws + WS_BBR); float* BBI = (float*)(ws + WS_BBI);
        for (int c = 0; c < 16; ++c) { const float br = A.in[I_BRE][gt * 16 + c], bi = A.in[I_BIM][gt * 16 + c]; BBR[gt * 16 + c] = cr * br - ci * bi; BBI[gt * 16 + c] = cr * bi + ci * br; }
    }
    if (gt >= 4096 && gt < 4096 + 8 * 130) {
        const int q = gt - 4096, h = q / 130, idx = q % 130; const float* tb = A.in[I_RELB]; const float far = tb[31 * 8 + h];
        float v;
        if (idx == 0) v = -INFINITY; else if (idx == 129) v = 0.f; else v = (tb[t5_bucket(idx - 1) * 8 + h] - far) * LOG2E;
        ((float*)(ws + WS_LUT))[q] = v;
    }
    if (gt == 8192) {
        float s1 = 0.f, s2 = 0.f;
        for (int i = 0; i < 64; ++i) { s1 += A.in[I_LQ1][i] * A.in[I_LK1][i]; s2 += A.in[I_LQ2][i] * A.in[I_LK2][i]; }
        *(float*)(ws + WS_LAM) = expf(s1) - expf(s2) + LAM_INIT;
    }
}

template <class F> __device__ __forceinline__ void small_gemm(LAS unsigned char* lds, const bf16* A, const bf16* Bt, int N, int K, int cu, int ncu, float* ssout, F&& epi) {
    int tid_o = threadIdx.x; asm volatile("" : "+v"(tid_o));
    const int tid = tid_o, lane = tid & 63, wid = __builtin_amdgcn_readfirstlane(tid >> 6), i = lane & 15, kq = lane >> 4;
    const int nk = K / 32, ks0 = (wid * nk) / 8, ks1 = ((wid + 1) * nk) / 8, nslab = N / 16;
    LAS float* part = (LAS float*)lds;
    for (int slab = cu; slab < nslab; slab += ncu) {
        f32x4 acc0 = {0.f, 0.f, 0.f, 0.f}, acc1 = {0.f, 0.f, 0.f, 0.f};
        const bf16* bp = Bt + (size_t)(slab * 16 + i) * K + kq * 8;
        const bf16* ap0 = A + (size_t)i * K + kq * 8; const bf16* ap1 = ap0 + (size_t)16 * K;
#pragma unroll 4
        for (int ks = ks0; ks < ks1; ++ks) {
            const bf16x8 b = *(const bf16x8*)(bp + ks * 32), a0 = *(const bf16x8*)(ap0 + ks * 32), a1 = *(const bf16x8*)(ap1 + ks * 32);
            acc0 = __builtin_amdgcn_mfma_f32_16x16x32_bf16(a0, b, acc0, 0, 0, 0);
            acc1 = __builtin_amdgcn_mfma_f32_16x16x32_bf16(a1, b, acc1, 0, 0, 0);
        }
        asm volatile("s_nop 15\n\ts_nop 15" : "+v"(acc0), "+v"(acc1));
#pragma unroll
        for (int r = 0; r < 4; ++r) { part[wid * 512 + (4 * kq + r) * 16 + i] = acc0[r]; part[wid * 512 + (16 + 4 * kq + r) * 16 + i] = acc1[r]; }
        WG_SYNC();
        float v = 0.f;
#pragma unroll
        for (int w = 0; w < 8; ++w) v += part[w * 512 + tid];
        const float h = epi(tid >> 4, slab * 16 + (tid & 15), v);
        if (ssout) { float q = h * h; q += __shfl_xor(q, 1); q += __shfl_xor(q, 2); q += __shfl_xor(q, 4); q += __shfl_xor(q, 8); if ((tid & 15) == 0) ssout[(tid >> 4) * nslab + slab] = q; }
        WG_SYNC();
    }
}
__device__ __forceinline__ void sample_rstd_table(LAS unsigned char* lds, const float* ss) {
    int tid_o = threadIdx.x; asm volatile("" : "+v"(tid_o));
    const int tid = tid_o, row = tid >> 4, j = tid & 15;
    float q = 0.f;
#pragma unroll
    for (int e = 0; e < 8; ++e) q += ss[row * 128 + j * 8 + e];
    q += __shfl_xor(q, 1); q += __shfl_xor(q, 2); q += __shfl_xor(q, 4); q += __shfl_xor(q, 8);
    if (j == 0) ((LAS float*)(lds + RS_OFF))[row] = 1.0f / sqrtf(q * (1.0f / 2048.0f) + NEPS);
    WG_SYNC();
}
template <int CTRL> __device__ __forceinline__ float dppf(float x) { return __builtin_bit_cast(float, __builtin_amdgcn_update_dpp(0, __builtin_bit_cast(int, x), CTRL, 0xf, 0xf, true)); }
__device__ __forceinline__ float dot4(f32x4 a, f32x4 b) { return (a.x * b.x + a.y * b.y) + (a.z * b.z + a.w * b.w); }
struct KV4 { f32x4 k0, k1, v0, v1; };
typedef __bf16 bf16x2_t __attribute__((ext_vector_type(2)));
__device__ __forceinline__ float dot2bf(unsigned k, unsigned q, float acc) { return __builtin_amdgcn_fdot2_f32_bf16(__builtin_bit_cast(bf16x2_t, k), __builtin_bit_cast(bf16x2_t, q), acc, false); }
__device__ __forceinline__ unsigned cvtpk_u(float lo, float hi) { typedef float f32x2_t __attribute__((ext_vector_type(2))); f32x2_t v = {lo, hi}; return __builtin_bit_cast(unsigned, __builtin_convertvector(v, bf16x2_t)); }
__device__ __forceinline__ void decode_unit(const Args& A, int unit, LAS unsigned char* lds, int wid, int lane_in) {
    unsigned char* ws = A.ws;
    int lane = lane_in; asm volatile("" : "+v"(lane));
    const int bh = unit >> 2, split = unit & 3, b = bh >> 3, h = bh & 7, r = lane >> 4, c = lane & 15;
    const float* QS = (const float*)(ws + WS_QS);
    unsigned qp[4][4];
#pragma unroll
    for (int i = 0; i < 4; ++i) { const float* qp_ = QS + (size_t)(b * 4 + i) * 1024 + h * 128 + 8 * c; const f32x4 a = *(const f32x4*)qp_, bq = *(const f32x4*)(qp_ + 4);
        qp[i][0] = pk2(a.x, a.y); qp[i][1] = pk2(a.z, a.w); qp[i][2] = pk2(bq.x, bq.y); qp[i][3] = pk2(bq.z, bq.w); }
    float m[4], l[4]; f32x4 acc[4][2][2];
#pragma unroll
    for (int i = 0; i < 4; ++i) { m[i] = -INFINITY; l[i] = 0.f;
#pragma unroll
        for (int e = 0; e < 2; ++e) { acc[i][e][0] = (f32x4){0.f, 0.f, 0.f, 0.f}; acc[i][e][1] = (f32x4){0.f, 0.f, 0.f, 0.f}; } }
    const int* pt = (const int*)A.in[I_PT] + b * NPAGE + split * 32 + wid;
    const int ph0 = pt[0], ph1 = pt[8], ph2 = pt[16], ph3 = pt[24];
    const float* CK = A.in[I_CK]; const float* CV = A.in[I_CV];
    const LAS float* lut = (const LAS float*)(lds + LUT_OFF) + h * 130;
#define DEC_LOAD(buf, it_) do { const int itc_ = (it_) < 127 ? (it_) : 127; const int pg_ = itc_ >> 5; const int ph_ = pg_ == 0 ? ph0 : (pg_ == 1 ? ph1 : (pg_ == 2 ? ph2 : ph3)); \
        const size_t off_ = ((size_t)ph_ * PAGESZ + (size_t)(((itc_ & 31) << 2) + r)) * 1024 + h * 128 + 8 * c; \
        buf.k0 = __builtin_nontemporal_load((const f32x4*)(CK + off_)); buf.k1 = __builtin_nontemporal_load((const f32x4*)(CK + off_ + 4)); \
        buf.v0 = __builtin_nontemporal_load((const f32x4*)(CV + off_)); buf.v1 = __builtin_nontemporal_load((const f32x4*)(CV + off_ + 4)); } while (0)
#define DEC_COMPUTE(buf, it_) do { float s[4]; \
        const unsigned kp0_ = cvtpk_u(buf.k0.x, buf.k0.y), kp1_ = cvtpk_u(buf.k0.z, buf.k0.w), kp2_ = cvtpk_u(buf.k1.x, buf.k1.y), kp3_ = cvtpk_u(buf.k1.z, buf.k1.w); \
        _Pragma("unroll") for (int i = 0; i < 4; ++i) { float p_ = dot2bf(kp0_, qp[i][0], 0.f); p_ = dot2bf(kp1_, qp[i][1], p_); p_ = dot2bf(kp2_, qp[i][2], p_); p_ = dot2bf(kp3_, qp[i][3], p_); \
            p_ += dppf<0xB1>(p_); p_ += dppf<0x4E>(p_); p_ += dppf<0x141>(p_); s[i] = p_; } \
        const int page_ = split * 32 + wid + 8 * ((it_) >> 5); \
        if (page_ == NPAGE - 1) { const int kpos_ = page_ * PAGESZ + (((it_) & 31) << 2) + r; \
            _Pragma("unroll") for (int i = 0; i < 4; ++i) { int d_ = PASTLEN + i - kpos_ + 1; d_ = d_ > 129 ? 129 : d_; s[i] += lut[d_]; } } \
        bool need_ = false; \
        _Pragma("unroll") for (int i = 0; i < 4; ++i) need_ |= s[i] > m[i]; \
        if (__any(need_)) { \
            _Pragma("unroll") for (int i = 0; i < 4; ++i) { const float mn_ = fmaxf(m[i], s[i]); const float a_ = __builtin_amdgcn_exp2f(m[i] - mn_); m[i] = mn_; l[i] *= a_; const float ao_ = dppf<0x128>(a_); \
                acc[i][0][0] = acc[i][0][0] * a_; acc[i][0][1] = acc[i][0][1] * a_; acc[i][1][0] = acc[i][1][0] * ao_; acc[i][1][1] = acc[i][1][1] * ao_; } } \
        _Pragma("unroll") for (int i = 0; i < 4; ++i) { const float p_ = __builtin_amdgcn_exp2f(s[i] - m[i]); l[i] += p_; const float po_ = dppf<0x128>(p_); \
            acc[i][0][0] = acc[i][0][0] + buf.v0 * p_; acc[i][0][1] = acc[i][0][1] + buf.v1 * p_; acc[i][1][0] = acc[i][1][0] + buf.v0 * po_; acc[i][1][1] = acc[i][1][1] + buf.v1 * po_; } \
    } while (0)
    KV4 bA, bB, bC, bD, bE;
    DEC_LOAD(bA, 0); DEC_LOAD(bB, 1); DEC_LOAD(bC, 2); DEC_LOAD(bD, 3);
#pragma unroll 1
    for (int it = 0; it < 125; it += 5) {
        DEC_LOAD(bE, it + 4); DEC_COMPUTE(bA, it); __builtin_amdgcn_sched_barrier(0);
        DEC_LOAD(bA, it + 5); DEC_COMPUTE(bB, it + 1); __builtin_amdgcn_sched_barrier(0);
        DEC_LOAD(bB, it + 6); DEC_COMPUTE(bC, it + 2); __builtin_amdgcn_sched_barrier(0);
        DEC_LOAD(bC, it + 7); DEC_COMPUTE(bD, it + 3); __builtin_amdgcn_sched_barrier(0);
        DEC_LOAD(bD, it + 8); DEC_COMPUTE(bE, it + 4); __builtin_amdgcn_sched_barrier(0);
    }
    DEC_COMPUTE(bA, 125); __builtin_amdgcn_sched_barrier(0); DEC_COMPUTE(bB, 126); __builtin_amdgcn_sched_barrier(0); DEC_COMPUTE(bC, 127); __builtin_amdgcn_sched_barrier(0);
#undef DEC_LOAD
#undef DEC_COMPUTE
    int lane2 = lane; asm volatile("" : "+v"(lane2));
    const int r2 = lane2 >> 4, c2 = lane2 & 15;
    float m2[4][2], l2[4][2];
#pragma unroll
    for (int i = 0; i < 4; ++i) { m2[i][0] = m[i]; l2[i][0] = l[i]; m2[i][1] = __shfl_xor(m[i], 8); l2[i][1] = __shfl_xor(l[i], 8); }
#pragma unroll
    for (int sh = 16; sh <= 32; sh <<= 1)
#pragma unroll
        for (int i = 0; i < 4; ++i)
#pragma unroll
            for (int e = 0; e < 2; ++e) {
                const float mo = __shfl_xor(m2[i][e], sh), lo = __shfl_xor(l2[i][e], sh), mn = fmaxf(m2[i][e], mo);
                const float a = (m2[i][e] == -INFINITY) ? 0.f : __builtin_amdgcn_exp2f(m2[i][e] - mn), ao = (mo == -INFINITY) ? 0.f : __builtin_amdgcn_exp2f(mo - mn);
                l2[i][e] = l2[i][e] * a + lo * ao; m2[i][e] = mn;
#pragma unroll
                for (int hh = 0; hh < 2; ++hh)
#pragma unroll
                    for (int x = 0; x < 4; ++x) { const float vo = __shfl_xor(acc[i][e][hh][x], sh); acc[i][e][hh][x] = acc[i][e][hh][x] * a + vo * ao; }
            }
    LAS float* WM = (LAS float*)lds;
    if (r2 == 0) {
#pragma unroll
        for (int i = 0; i < 4; ++i)
#pragma unroll
            for (int e = 0; e < 2; ++e) { const int mp = (c2 >> 3) ^ e; LAS float* dst = WM + (size_t)(wid * 8 + i * 2 + mp) * 130;
                *(LAS f32x4*)(dst + 2 + 8 * c2) = acc[i][e][0]; *(LAS f32x4*)(dst + 2 + 8 * c2 + 4) = acc[i][e][1];
                if ((c2 & 7) == 0) { dst[0] = m2[i][e]; dst[1] = l2[i][e]; } }
    }
    WG_SYNC();
    {
        const int tid = wid * 64 + lane2, imp = tid >> 6, e2 = (tid & 63) * 2;
        float mm = -INFINITY;
#pragma unroll
        for (int w = 0; w < 8; ++w) mm = fmaxf(mm, WM[(w * 8 + imp) * 130]);
        float ll = 0.f, a0 = 0.f, a1 = 0.f;
#pragma unroll
        for (int w = 0; w < 8; ++w) { const LAS float* src = WM + (w * 8 + imp) * 130; const float mw = src[0]; const float f = (mw == -INFINITY) ? 0.f : __builtin_amdgcn_exp2f(mw - mm);
            ll += src[1] * f; a0 += src[2 + e2] * f; a1 += src[3 + e2] * f; }
        float* dst = (float*)(ws + WS_PART) + (size_t)(unit * 8 + imp) * 130;
        dst[2 + e2] = a0; dst[3 + e2] = a1; if ((tid & 63) == 0) { dst[0] = mm; dst[1] = ll; }
    }
    WG_SYNC();
}

struct SsmConst { float abr, abi, dsk, glub; bf16x8 b1[4][2]; bf16x8 c2[4]; bf16x8 w3; };
constexpr int SSM_WL = 15872, SSM_HS = 10240, SSM_GS = 10240 + 4352, SSM_EX = 126976;
__device__ __forceinline__ bf16x8 pack_bf8(float a0, float a1, float a2, float a3, float a4, float a5, float a6, float a7) {
    v4u w; w.x = pk2(a0, a1); w.y = pk2(a2, a3); w.z = pk2(a4, a5); w.w = pk2(a6, a7); return __builtin_bit_cast(bf16x8, w);
}
__device__ __forceinline__ void ssm_build_const(const Args& A, int g, int lane, SsmConst& C) {
    unsigned char* ws = A.ws; const int i = lane & 15, kq = lane >> 4;
    const float* AB = (const float*)(ws + WS_AB); C.abr = AB[(g * 64 + lane) * 2]; C.abi = AB[(g * 64 + lane) * 2 + 1];
    C.dsk = A.in[I_SD][g * 16 + i]; C.glub = A.in[I_GLUB][g * 16 + i];
    const bf16x8 zero = {0, 0, 0, 0, 0, 0, 0, 0};
#pragma unroll
    for (int sb = 0; sb < 4; ++sb)
#pragma unroll
        for (int part = 0; part < 2; ++part) {
            C.b1[sb][part] = zero;
            if (kq < 2) { const float* p = (const float*)(ws + (part ? WS_BBI : WS_BBR)) + (size_t)(g * 64 + 16 * sb + i) * 16 + 8 * kq; C.b1[sb][part] = pack_bf8(p[0], p[1], p[2], p[3], p[4], p[5], p[6], p[7]); }
        }
    const float* cre = A.in[I_CRE] + (size_t)(g * 16 + i) * 64; const float* cim = A.in[I_CIM] + (size_t)(g * 16 + i) * 64;
#pragma unroll
    for (int s = 0; s < 4; ++s) { const int n0 = 16 * s + 4 * kq; C.c2[s] = pack_bf8(cre[n0], -cim[n0], cre[n0 + 1], -cim[n0 + 1], cre[n0 + 2], -cim[n0 + 2], cre[n0 + 3], -cim[n0 + 3]); }
    C.w3 = zero;
    if (kq < 2) { const float* w = A.in[I_GLUW] + (size_t)(g * 16 + 8 * kq) * 16 + i; C.w3 = pack_bf8(w[0], w[16], w[32], w[48], w[64], w[80], w[96], w[112]); }
}
template <bool FULL> __device__ __forceinline__ void ssm_tile(const SsmConst& C, const float* us, int ntok, bf16* gs, float& hr, float& hi, LAS unsigned char* wl, int lane) {
    const int i = lane & 15, kq = lane >> 4;
    const bf16x8 zero = {0, 0, 0, 0, 0, 0, 0, 0}; const f32x4 fz = {0.f, 0.f, 0.f, 0.f};
    bf16x8 a1 = zero;
    if (kq < 2 && i < ntok) { const float* p = us + (size_t)i * 1024 + 8 * kq; const f32x4 x0 = *(const f32x4*)p, x1 = *(const f32x4*)(p + 4); a1 = pack_bf8(x0.x, x0.y, x0.z, x0.w, x1.x, x1.y, x1.z, x1.w); }
    LAS float* BUs = (LAS float*)wl;
    { f32x4 dd[4][2];
#pragma unroll
    for (int sb = 0; sb < 4; ++sb)
#pragma unroll
        for (int part = 0; part < 2; ++part) dd[sb][part] = __builtin_amdgcn_mfma_f32_16x16x32_bf16(a1, C.b1[sb][part], fz, 0, 0, 0);
    asm volatile("s_nop 15\n\ts_nop 15" : "+v"(dd[0][0]), "+v"(dd[0][1]), "+v"(dd[1][0]), "+v"(dd[1][1]), "+v"(dd[2][0]), "+v"(dd[2][1]), "+v"(dd[3][0]), "+v"(dd[3][1]));
#pragma unroll
    for (int sb = 0; sb < 4; ++sb)
#pragma unroll
        for (int part = 0; part < 2; ++part) *(LAS f32x4*)(BUs + (part * 64 + 16 * sb + i) * 20 + 4 * kq) = dd[sb][part]; }
    f32x4 br[4], bi[4];
#pragma unroll
    for (int qd = 0; qd < 4; ++qd) { br[qd] = *(const LAS f32x4*)(BUs + lane * 20 + 4 * qd); bi[qd] = *(const LAS f32x4*)(BUs + (64 + lane) * 20 + 4 * qd); }
    LAS unsigned* Hs = (LAS unsigned*)(wl + SSM_HS);
#pragma unroll
    for (int t = 0; t < 16; ++t) {
        if (t < ntok) { const float bur = br[t >> 2][t & 3], bui = bi[t >> 2][t & 3];
            const float nr = C.abr * hr - C.abi * hi + bur, ni = C.abr * hi + C.abi * hr + bui; hr = nr; hi = ni;
            if (FULL) Hs[t * 68 + lane] = pk2(hr, hi); }
    }
    if (FULL) {
        f32x4 y = fz;
#pragma unroll
        for (int s = 0; s < 4; ++s) { const bf16x8 a2 = *(const LAS bf16x8*)((LAS unsigned char*)Hs + i * 272 + (32 * s + 8 * kq) * 2); y = __builtin_amdgcn_mfma_f32_16x16x32_bf16(a2, C.c2[s], y, 0, 0, 0); }
        MFMA_SETTLE(y);
        float gg[4];
        LAS unsigned short* Gs = (LAS unsigned short*)(wl + SSM_GS);
#pragma unroll
        for (int r = 0; r < 4; ++r) { const int tok = 4 * kq + r; float u = 0.f; if (tok < ntok) u = us[(size_t)tok * 1024 + i]; gg[r] = gelu_tanh(y[r] + C.dsk * u); Gs[tok * 24 + i] = (unsigned short)f2bf(gg[r]); }
        bf16x8 a3 = zero;
        if (kq < 2) a3 = *(const LAS bf16x8*)(Gs + i * 24 + 8 * kq);
        f32x4 gp = __builtin_amdgcn_mfma_f32_16x16x32_bf16(a3, C.w3, fz, 0, 0, 0);
        MFMA_SETTLE(gp);
#pragma unroll
        for (int r = 0; r < 4; ++r) { const int tok = 4 * kq + r; if (tok < ntok) gs[(size_t)tok * 1024 + i] = (bf16)f2bf(gg[r] * sigmoidf_(gp[r] + C.glub)); }
    }
}
__device__ __forceinline__ void ssm_prompt_unit(const Args& A, int b, int g, LAS unsigned char* lds, int wid, int lane) {
    unsigned char* ws = A.ws; LAS unsigned char* wl = lds + wid * SSM_WL;
    SsmConst C; ssm_build_const(A, g, lane, C);
    const size_t row0 = (size_t)b * SEQL + wid * 512;
    const float* us = (const float*)(ws + WS_US) + row0 * 1024 + g * 16; bf16* gs = (bf16*)(ws + WS_GS) + row0 * 1024 + g * 16;
    float hr = 0.f, hi = 0.f;
    for (int tile = 0; tile < 32; ++tile) ssm_tile<false>(C, us + (size_t)tile * 16 * 1024, 16, nullptr, hr, hi, wl, lane);
    LAS float* EX = (LAS float*)(lds + SSM_EX);
    EX[(wid * 64 + lane) * 2] = hr; EX[(wid * 64 + lane) * 2 + 1] = hi;
    WG_SYNC();
    float pr = C.abr, pi = C.abi;
#pragma unroll
    for (int k = 0; k < 9; ++k) { const float nr = pr * pr - pi * pi, ni = 2.f * pr * pi; pr = nr; pi = ni; }
    float sr = 0.f, si = 0.f;
    for (int w = 0; w < wid; ++w) { const float er = EX[(w * 64 + lane) * 2], ei = EX[(w * 64 + lane) * 2 + 1]; const float nr = pr * sr - pi * si + er, ni = pr * si + pi * sr + ei; sr = nr; si = ni; }
    hr = sr; hi = si;
    for (int tile = 0; tile < 32; ++tile) ssm_tile<true>(C, us + (size_t)tile * 16 * 1024, 16, gs + (size_t)tile * 16 * 1024, hr, hi, wl, lane);
    if (wid == 7) { A.out[O_SREP + (size_t)(b * 64 + g) * 64 + lane] = hr; A.out[O_SIMP + (size_t)(b * 64 + g) * 64 + lane] = hi; }
    WG_SYNC();
}
__device__ __forceinline__ void ssm_sample_wave(const Args& A, int bs, int g, LAS unsigned char* lds, int wid, int lane) {
    unsigned char* ws = A.ws; LAS unsigned char* wl = lds + wid * SSM_WL;
    SsmConst C; ssm_build_const(A, g, lane, C);
    const size_t si_ = (size_t)(bs * 64 + g) * 64 + lane;
    float hr = A.in[I_SRE][si_], hi = A.in[I_SIM][si_];
    ssm_tile<true>(C, (const float*)(ws + WS_USS) + (size_t)bs * 4 * 1024 + g * 16, 4, (bf16*)(ws + WS_GSS) + (size_t)bs * 4 * 1024 + g * 16, hr, hi, wl, lane);
    A.out[O_SRES + si_] = hr; A.out[O_SIMS + si_] = hi;
}

__device__ __forceinline__ void unpack16(const bf16* p, float (&v)[16]) {
    const v4u a = *(const GAS v4u*)p, b = *(const GAS v4u*)(p + 8);
    v[0] = bflo(a.x); v[1] = bfhi(a.x); v[2] = bflo(a.y); v[3] = bfhi(a.y); v[4] = bflo(a.z); v[5] = bfhi(a.z); v[6] = bflo(a.w); v[7] = bfhi(a.w);
    v[8] = bflo(b.x); v[9] = bfhi(b.x); v[10] = bflo(b.y); v[11] = bfhi(b.y); v[12] = bflo(b.z); v[13] = bfhi(b.z); v[14] = bflo(b.w); v[15] = bfhi(b.w);
}
__device__ __forceinline__ void store16(bf16* p, const float (&v)[16]) {
    v4u a, b; a.x = pk2(v[0], v[1]); a.y = pk2(v[2], v[3]); a.z = pk2(v[4], v[5]); a.w = pk2(v[6], v[7]); b.x = pk2(v[8], v[9]); b.y = pk2(v[10], v[11]); b.z = pk2(v[12], v[13]); b.w = pk2(v[14], v[15]);
    *(GAS v4u*)p = a; *(GAS v4u*)(p + 8) = b;
}
__device__ __forceinline__ void fin_ssm_row(const Args& A, const bf16* gsrow, bf16* oarow, int lane) {
    float v[16]; unpack16(gsrow + 16 * lane, v);
    float s = 0.f;
#pragma unroll
    for (int k = 0; k < 16; ++k) s += v[k] * v[k];
    s = wave_sum(s); const float rs = 1.0f / sqrtf(s * (1.0f / 1024.0f) + NEPS);
    const float* gn = A.in[I_SOUTG] + 16 * lane;
#pragma unroll
    for (int k = 0; k < 16; ++k) v[k] = v[k] * rs * gn[k];
    store16(oarow + 1024 + 16 * lane, v);
}
__device__ __forceinline__ void fin_prompt_row(const Args& A, int row, float lam, int lane) {
    unsigned char* ws = A.ws;
    float a[16], b2[16]; unpack16((const bf16*)(ws + WS_O1) + (size_t)row * 1024 + 16 * lane, a); unpack16((const bf16*)(ws + WS_O2) + (size_t)row * 1024 + 16 * lane, b2);
    float s = 0.f;
#pragma unroll
    for (int k = 0; k < 16; ++k) { a[k] = a[k] - lam * b2[k]; s += a[k] * a[k]; }
    s += __shfl_xor(s, 1); s += __shfl_xor(s, 2); s += __shfl_xor(s, 4);
    const float rs = (1.0f - LAM_INIT) / sqrtf(s * (1.0f / 128.0f) + SUBLN_EPS);
    const float* gn = A.in[I_SUBLNG] + 16 * lane;
#pragma unroll
    for (int k = 0; k < 16; ++k) a[k] = a[k] * rs * gn[k];
    bf16* oarow = (bf16*)(ws + WS_OA) + (size_t)row * 2048;
    store16(oarow + 16 * lane, a);
    fin_ssm_row(A, (const bf16*)(ws + WS_GS) + (size_t)row * 1024, oarow, lane);
}
__device__ __forceinline__ void fin_sample_attn(const Args& A, int task, float lam, LAS unsigned char* lds, int lane) {
    unsigned char* ws = A.ws; const int i = task & 3, h = (task >> 2) & 7, b = task >> 5, row = b * 4 + i;
    const LAS float* lut = (const LAS float*)(lds + LUT_OFF) + h * 130;
    const float* QS = (const float*)(ws + WS_QS); const float* KS = A.out + O_KS; const float* VS = A.out + O_VS;
    float o[2][2];
#pragma unroll
    for (int mp = 0; mp < 2; ++mp) {
        const float qv = QS[(size_t)row * 1024 + h * 128 + mp * 64 + lane];
        float sn[4];
#pragma unroll
        for (int j = 0; j < 4; ++j) { const float kv = KS[(size_t)(b * 4 + j) * 1024 + h * 128 + mp * 64 + lane]; sn[j] = wave_sum(qv * kv) + lut[(i - j) + 1 < 0 ? 0 : (i - j) + 1]; }
        const float* P = (const float*)(ws + WS_PART) + (size_t)((b * 8 + h) * 4) * 8 * 130 + (size_t)(i * 2 + mp) * 130;
        float mm = -INFINITY;
#pragma unroll
        for (int s = 0; s < 4; ++s) mm = fmaxf(mm, P[(size_t)s * 8 * 130]);
#pragma unroll
        for (int j = 0; j < 4; ++j) if (j <= i) mm = fmaxf(mm, sn[j]);
        float ll = 0.f, a0 = 0.f, a1 = 0.f;
#pragma unroll
        for (int s = 0; s < 4; ++s) { const float* ps = P + (size_t)s * 8 * 130; const float f = __builtin_amdgcn_exp2f(ps[0] - mm); ll += ps[1] * f; a0 += ps[2 + 2 * lane] * f; a1 += ps[3 + 2 * lane] * f; }
#pragma unroll
        for (int j = 0; j < 4; ++j) if (j <= i) { const float p = __builtin_amdgcn_exp2f(sn[j] - mm); const float* vr = VS + (size_t)(b * 4 + j) * 1024 + h * 128 + 2 * lane; ll += p; a0 += p * vr[0]; a1 += p * vr[1]; }
        const float inv = 1.0f / ll; o[mp][0] = a0 * inv; o[mp][1] = a1 * inv;
    }
    const float d0 = o[0][0] - lam * o[1][0], d1 = o[0][1] - lam * o[1][1];
    const float s = wave_sum(d0 * d0 + d1 * d1), rs = (1.0f - LAM_INIT) / sqrtf(s * (1.0f / 128.0f) + SUBLN_EPS);
    const float* gn = A.in[I_SUBLNG] + h * 128 + 2 * lane;
    *(GAS unsigned*)((bf16*)(ws + WS_OAS) + (size_t)row * 2048 + h * 128 + 2 * lane) = pk2(d0 * rs * gn[0], d1 * rs * gn[1]);
}

__device__ __forceinline__ void unpack8(v4u a, float (&v)[8]) { v[0] = bflo(a.x); v[1] = bfhi(a.x); v[2] = bflo(a.y); v[3] = bfhi(a.y); v[4] = bflo(a.z); v[5] = bfhi(a.z); v[6] = bflo(a.w); v[7] = bfhi(a.w); }
__device__ __forceinline__ float siluf_(float x) { return x * sigmoidf_(x); }
__device__ __forceinline__ void p4b_conv(const Args& A, int gtid, int nthreads) {
    unsigned char* ws = A.ws;
    { const float* GF = (const float*)(ws + WS_GF); const float* VF = (const float*)(ws + WS_VF); const float* GL = (const float*)(ws + WS_GL); bf16* HFF = (bf16*)(ws + WS_HFF);
      for (int it = gtid; it < 64 * DFF; it += nthreads) {
        const int pr = it / DFF, j = it % DFF, p = pr >> 1, r = pr & 1; const bool first = (p & 15) == 0;
        const float gm2 = first ? 0.f : GL[(size_t)((p - 1) * 2) * DFF + j], gm1 = first ? 0.f : GL[(size_t)((p - 1) * 2 + 1) * DFF + j];
        const float g0 = GF[(size_t)(p * 2) * DFF + j], g1 = GF[(size_t)(p * 2 + 1) * DFF + j];
        const float x0 = r == 0 ? gm2 : gm1, x1 = r == 0 ? gm1 : g0, x2 = r == 0 ? g0 : g1;
        const float cv = A.in[I_CONVB][j] + A.in[I_CONVW][j] * x0 + A.in[I_CONVW][DFF + j] * x1 + A.in[I_CONVW][2 * DFF + j] * x2;
        HFF[(size_t)(p * 256 + r) * DFF + j] = (bf16)f2bf(siluf_(cv) * VF[(size_t)pr * DFF + j]);
      } }
    const float* GU = (const float*)(ws + WS_GUS); const float* VU = (const float*)(ws + WS_VUS); bf16* HS = (bf16*)(ws + WS_HFFS);
    for (int it = gtid; it < TSM * DFF; it += nthreads) {
        const int row = it / DFF, j = it % DFF, bs = row >> 2, t = row & 3;
        const float* sc = A.in[I_SCONV] + (size_t)bs * 2 * DFF + j;
        const float x2 = GU[(size_t)row * DFF + j];
        const float x1 = t >= 1 ? GU[(size_t)(row - 1) * DFF + j] : sc[DFF];
        const float x0 = t >= 2 ? GU[(size_t)(row - 2) * DFF + j] : (t == 1 ? sc[DFF] : sc[0]);
        const float cv = A.in[I_CONVB][j] + A.in[I_CONVW][j] * x0 + A.in[I_CONVW][DFF + j] * x1 + A.in[I_CONVW][2 * DFF + j] * x2;
        HS[(size_t)row * DFF + j] = (bf16)f2bf(siluf_(cv) * VU[(size_t)row * DFF + j]);
    }
}
#ifndef PH_MASK
#define PH_MASK 0xFFFF
#endif
#define PHEN(k) (((PH_MASK) >> (k)) & 1)
#ifndef DEC_SLOT
#define DEC_SLOT(v) ((v) & 3)
#endif
__global__ void __launch_bounds__(NWAVES * 64, 2) hymba_fwd(Args args) {
    extern __shared__ __attribute__((aligned(16))) unsigned char lds_raw[];
    LAS unsigned char* lds = (LAS unsigned char*)lds_raw;
    const int G = gridDim.x;
    unsigned char* ws = args.ws;
#define PH_LOCALS() int tid = threadIdx.x; asm volatile("" : "+v"(tid)); int bx = blockIdx.x; asm volatile("" : "+s"(bx)); \
    const int lane = tid & 63, wave = __builtin_amdgcn_readfirstlane(tid >> 6), vcu = (G % 8 == 0) ? (bx % 8) * (G / 8) + bx / 8 : bx; \
    const int gw = vcu * NWAVES + wave, NGW = G * NWAVES, gtid = gw * 64 + lane, NT_ALL = NGW * 64; (void)lane; (void)wave; (void)vcu; (void)gw; (void)NGW; (void)gtid; (void)NT_ALL; (void)bx
    XcdBarrier bar;
    {
        PH_LOCALS();
        gu32* ctl = (gu32*)(ws + WS_CTL);
        for (int u = tid; u < (LDS_BYTES - LDSCTL_OFF) / 4; u += NWAVES * 64) ((LAS unsigned*)(lds + LDSCTL_OFF))[u] = 0u;
        __syncthreads();
        volatile LAS unsigned* MISC = (volatile LAS unsigned*)(lds + MISC_OFF);
        bar = xcd_barrier_post((unsigned*)(ctl + CW_BAR), MISC + 8);
    }

    if (PHEN(0)) { PH_LOCALS();
    p0_prologue(args, lds, vcu, G, wave, lane);
    }
    xcd_barrier(bar);

    {
        PH_LOCALS();
        for (int u = tid; u < 8 * 130; u += NTHR) ((LAS float*)(lds + LUT_OFF))[u] = ((const float*)(ws + WS_LUT))[u];
        __syncthreads();
    }

    if (PHEN(1)) { PH_LOCALS();
    {
        pg8::Gemm g{(const pg8::bf16_t*)(ws + WS_XB), (const pg8::bf16_t*)(ws + WS_WIN), TP, DIN, DMODEL}; pg8::StaticOrder S; S.init(TP, DIN, G, bx);
        pg8::EpiIn E{(const float*)(ws + WS_RSX), (pg8::bf16_t*)(ws + WS_QB), (pg8::bf16_t*)(ws + WS_KB), (pg8::bf16_t*)(ws + WS_VB), (float*)(ws + WS_US), args.out + O_KP, args.out + O_VP, C2F};
        pg8::gemm_phase<pg8::EpiIn, pg8::StaticOrder, true, true>(lds + RING_OFF, g, S, E);
    }
    {
        pg8::Gemm g{(const pg8::bf16_t*)(ws + WS_PB), (const pg8::bf16_t*)(ws + WS_WPP), TP, DMODEL, PLED}; pg8::StaticOrder S; S.init(TP, DMODEL, G, bx);
        pg8::EpiPlain E{(pg8::bf16_t*)(ws + WS_PROJ), DMODEL};
        pg8::gemm_phase<pg8::EpiPlain, pg8::StaticOrder, true, true>(lds + RING_OFF, g, S, E);
    }
    {
        const float* rsx = (const float*)(ws + WS_RSX) + TP; float* QS = (float*)(ws + WS_QS); float* USS = (float*)(ws + WS_USS); float* out = args.out;
        small_gemm(lds, (const bf16*)(ws + WS_XSB), (const bf16*)(ws + WS_WIN), DIN, DMODEL, vcu, G, nullptr, [=](int row, int col, float v) -> float {
            v *= rsx[row]; const int sec = col >> 10, c = col & 1023;
            if (sec == 0) QS[row * 1024 + c] = v * C2F; else if (sec == 1) out[O_KS + row * 1024 + c] = v; else if (sec == 2) out[O_VS + row * 1024 + c] = v; else USS[row * 1024 + c] = v;
            return v; });
        float* PJ = (float*)(ws + WS_PROJS);
        small_gemm(lds, (const bf16*)(ws + WS_PSB), (const bf16*)(ws + WS_WPP), DMODEL, PLED, vcu, G, nullptr, [=](int row, int col, float v) -> float { PJ[row * 2048 + col] = v; return v; });
    }
    }
    xcd_barrier(bar);

    if (PHEN(2)) { PH_LOCALS();
    if (PHEN(10)) { if (vcu < 256) decode_unit(args, vcu, lds, wave, lane); }
    if (PHEN(11)) {
        const attn_body::bf16* Qp = (const attn_body::bf16*)(ws + WS_QB); const attn_body::bf16* Kp = (const attn_body::bf16*)(ws + WS_KB); const attn_body::bf16* Vp = (const attn_body::bf16*)(ws + WS_VB);
        { const int L0 = vcu * 4;
            const int pair = L0 >> 4, s4 = (L0 >> 2) & 3, b = pair >> 5, vh = pair & 31, hh = vh >> 2, mp = (vh >> 1) & 1, vhalf = vh & 1;
            attn_body::bf16* Op = (attn_body::bf16*)(ws + (mp ? WS_O2 : WS_O1));
            for (int u = tid; u < 640; u += NTHR) { const int d = u - 256; ((LAS float*)(lds + LUTX_OFF))[u] = d < 0 ? -INFINITY : (d < 128 ? ((const LAS float*)(lds + LUT_OFF))[hh * 130 + 1 + d] : 0.f); }
            __syncthreads();
            attn_body::lds_cfptr lut = (attn_body::lds_cfptr)(lds + LUTX_OFF);
#pragma unroll 1
            for (int i = 0; i < 4; ++i) { const int qb = (i == 0) ? s4 : (i == 1) ? 7 - s4 : (i == 2) ? 8 + s4 : 15 - s4;
                attn_body::attn_unit<8>(b, 2 * hh + mp, 2 * hh + vhalf, qb, Qp, Kp, Vp, Op, (char*)lds_raw + RING_OFF, lut); }
        }
    }
    __syncthreads();
    if (PHEN(12)) { if (vcu < 128) ssm_prompt_unit(args, vcu >> 6, vcu & 63, lds, wave, lane); }
    if (PHEN(13)) { const int u = gw - 128 * NWAVES; if (u >= 0 && u < 512) ssm_sample_wave(args, u >> 6, u & 63, lds, wave, lane); }
    }
    xcd_barrier(bar);

    if (PHEN(3)) { PH_LOCALS(); const float lam = *(const float*)(ws + WS_LAM);
    for (int row = gw; row < TP; row += NGW) fin_prompt_row(args, row, lam, lane);
    for (int row = gw; row < TSM; row += NGW) fin_ssm_row(args, (const bf16*)(ws + WS_GSS) + (size_t)row * 1024, (bf16*)(ws + WS_OAS) + (size_t)row * 2048, lane);
    for (int t = NGW - 1 - gw; t < 256; t += NGW) fin_sample_attn(args, t, lam, lds, lane);
    }
    xcd_barrier(bar);

    if (PHEN(4)) { PH_LOCALS();
    {
        pg8::Gemm g{(const pg8::bf16_t*)(ws + WS_OA), (const pg8::bf16_t*)(ws + WS_WOUT), TP, DMODEL, DMODEL}; pg8::StaticOrder S; S.init(TP, DMODEL, G, bx);
        pg8::EpiRes<0> E{args.in[I_XP], (float*)(ws + WS_H1), (pg8::bf16_t*)(ws + WS_H1B), (float*)(ws + WS_SS1), nullptr, nullptr};
        if (G == 256) pg8::gemm_phase<pg8::EpiRes<0>, pg8::StaticOrder, false, true>(lds + RING_OFF, g, S, E);
        const float* xs = args.in[I_XS]; float* H1S = (float*)(ws + WS_H1S); bf16* H1SB = (bf16*)(ws + WS_H1SB);
        small_gemm(lds, (const bf16*)(ws + WS_OAS), (const bf16*)(ws + WS_WOUT), DMODEL, DMODEL, vcu, G, (float*)(ws + WS_SS1S), [=](int row, int col, float v) -> float {
            const float h = xs[row * 2048 + col] + v; H1S[row * 2048 + col] = h; H1SB[row * 2048 + col] = (bf16)f2bf(h); return h; });
    }
    }
    xcd_barrier(bar);

    if (PHEN(5)) { PH_LOCALS();
    {
        pg8::Gemm g{(const pg8::bf16_t*)(ws + WS_H1B), (const pg8::bf16_t*)(ws + WS_WUP), TP, 2 * DFF, DMODEL}; pg8::StaticOrder S; S.init(TP, 2 * DFF, G, bx);
        pg8::EpiUpConv E{(const float*)(ws + WS_SS1), (pg8::bf16_t*)(ws + WS_HFF), args.out + O_CONVP, args.in[I_CONVW], args.in[I_CONVB], (float*)(ws + WS_GF), (float*)(ws + WS_VF), (float*)(ws + WS_GL), (LAS float*)(lds + HAL_OFF), DFF};
        pg8::gemm_phase<pg8::EpiUpConv, pg8::StaticOrder, true, true>(lds + RING_OFF, g, S, E);
        sample_rstd_table(lds, (const float*)(ws + WS_SS1S));
        const LAS float* RS = (const LAS float*)(lds + RS_OFF); float* GU = (float*)(ws + WS_GUS); float* VU = (float*)(ws + WS_VUS); float* out = args.out;
        small_gemm(lds, (const bf16*)(ws + WS_H1SB), (const bf16*)(ws + WS_WUP), 2 * DFF, DMODEL, vcu, G, nullptr, [=](int row, int col, float v) -> float {
            v *= RS[row]; const int j = (col >> 8) * 128 + (col & 127);
            if (col & 128) VU[row * DFF + j] = v; else { GU[row * DFF + j] = v; if ((row & 3) >= 2) out[O_CONVS + (size_t)((row >> 2) * 2 + (row & 3) - 2) * DFF + j] = v; }
            return v; });
    }
    }
    xcd_barrier(bar);

    if (PHEN(6)) { PH_LOCALS();
    p4b_conv(args, gtid, NT_ALL);
    }
    xcd_barrier(bar);

    if (PHEN(7)) { PH_LOCALS();
    {
        pg8::Gemm g{(const pg8::bf16_t*)(ws + WS_HFF), (const pg8::bf16_t*)(ws + WS_WDN), TP, DMODEL, DFF}; pg8::StaticOrder S; S.init(TP, DMODEL, G, bx);
        pg8::EpiRes<0> E{(const float*)(ws + WS_H1), (float*)(ws + WS_H2), (pg8::bf16_t*)(ws + WS_H2B), (float*)(ws + WS_SS2), nullptr, nullptr};
        if (G == 256) pg8::gemm_phase<pg8::EpiRes<0>, pg8::StaticOrder, false, true>(lds + RING_OFF, g, S, E);
        const float* H1S = (const float*)(ws + WS_H1S); float* H2S = (float*)(ws + WS_H2S); bf16* H2SB = (bf16*)(ws + WS_H2SB);
        small_gemm(lds, (const bf16*)(ws + WS_HFFS), (const bf16*)(ws + WS_WDN), DMODEL, DFF, vcu, G, (float*)(ws + WS_SS2S), [=](int row, int col, float v) -> float {
            const float h = H1S[row * 2048 + col] + v; H2S[row * 2048 + col] = h; H2SB[row * 2048 + col] = (bf16)f2bf(h); return h; });
    }
    }
    xcd_barrier(bar);

    if (PHEN(8)) { PH_LOCALS();
    {
        pg8::Gemm g{(const pg8::bf16_t*)(ws + WS_H2B), (const pg8::bf16_t*)(ws + WS_WPG), TP, DMODEL, DMODEL}; pg8::StaticOrder S; S.init(TP, DMODEL, G, bx);
        pg8::EpiRes<1> E{(const float*)(ws + WS_H2), args.out + O_YP, nullptr, (float*)(ws + WS_SS3), (const float*)(ws + WS_SS2), (const pg8::bf16_t*)(ws + WS_PROJ)};
        if (G == 256) pg8::gemm_phase<pg8::EpiRes<1>, pg8::StaticOrder, false, true>(lds + RING_OFF, g, S, E);
        sample_rstd_table(lds, (const float*)(ws + WS_SS2S));
        const LAS float* RS = (const LAS float*)(lds + RS_OFF); const float* H2S = (const float*)(ws + WS_H2S); const float* PJ = (const float*)(ws + WS_PROJS); float* out = args.out;
        small_gemm(lds, (const bf16*)(ws + WS_H2SB), (const bf16*)(ws + WS_WPG), DMODEL, DMODEL, vcu, G, (float*)(ws + WS_SS3S), [=](int row, int col, float v) -> float {
            const float h = H2S[row * 2048 + col] + sigmoidf_(v * RS[row]) * PJ[row * 2048 + col]; out[O_YS + row * 2048 + col] = h; return h; });
    }
    }
    xcd_barrier(bar);

    if (PHEN(9)) { PH_LOCALS();
    for (int row = gw; row < TP + TSM; row += NGW) {
        float* yrow; float rs;
        if (row < TP) { yrow = args.out + O_YP + (size_t)row * DMODEL; rs = pg8::rstd8((const float*)(ws + WS_SS3) + (size_t)row * 8); }
        else { const int r = row - TP; yrow = args.out + O_YS + (size_t)r * DMODEL; const float* ss = (const float*)(ws + WS_SS3S) + r * 128; const float q = wave_sum(ss[lane] + ss[64 + lane]); rs = 1.0f / sqrtf(q * (1.0f / 2048.0f) + NEPS); }
        GAS f32x4* yr = (GAS f32x4*)yrow + lane; const GAS f32x4* gn = (const GAS f32x4*)args.in[I_NFING] + lane;
#pragma unroll
        for (int j = 0; j < 8; ++j) { f32x4 v = yr[64 * j]; const f32x4 g4 = gn[64 * j]; v = v * rs * g4; yr[64 * j] = v; }
    }
    }
}

extern "C" void kernel_launch(void* const* d_in, const int* in_sizes, int n_in, void* d_out, int out_size, void* d_ws, size_t ws_size, hipStream_t stream) {
    static int grid = 0;
    if (grid == 0) {
        if (n_in != N_IN || (size_t)out_size != O_END || ws_size < WS_END) { fprintf(stderr, "kernel_launch: unexpected shapes: n_in %d out %d ws %zu (need %d, %zu, %zu)\n", n_in, out_size, ws_size, (int)N_IN, (size_t)O_END, (size_t)WS_END); grid = -1; return; }
        int dev = 0, cus = 0, per_cu = 0;
        if (hipGetDevice(&dev) != hipSuccess || hipDeviceGetAttribute(&cus, hipDeviceAttributeMultiprocessorCount, dev) != hipSuccess) { grid = -1; return; }
        if (hipFuncSetAttribute((const void*)hymba_fwd, hipFuncAttributeMaxDynamicSharedMemorySize, LDS_BYTES) != hipSuccess) { fprintf(stderr, "kernel_launch: hipFuncSetAttribute failed\n"); grid = -1; return; }
        if (hipOccupancyMaxActiveBlocksPerMultiprocessor(&per_cu, (const void*)hymba_fwd, NWAVES * 64, LDS_BYTES) != hipSuccess || per_cu < 1) fprintf(stderr, "kernel_launch: occupancy query reports %d\n", per_cu);
        (void)hipGetLastError();
        grid = cus;
        if (grid != 256) fprintf(stderr, "kernel_launch: %d CUs (built for 256)\n", grid);
    }
    if (grid < 0) return;
    if (hipMemsetAsync((char*)d_ws + WS_CTL, 0, CTL_ZERO_BYTES, stream) != hipSuccess) return;
    Args a{};
    for (int i = 0; i < N_IN; ++i) a.in[i] = (const float*)d_in[i];
    a.out = (float*)d_out; a.ws = (unsigned char*)d_ws;
    hipLaunchKernelGGL(hymba_fwd, dim3(grid), dim3(NWAVES * 64), LDS_BYTES, stream, a);
}
```

```cpp
#include <hip/hip_runtime.h>
#include <hip/hip_bf16.h>
#include <cstdio>
#include <cstdint>
#include <cmath>
namespace pg8 {
#define PG8_LAS __attribute__((address_space(3)))
typedef unsigned short bf16_t;
typedef short bf16x8 __attribute__((ext_vector_type(8)));
typedef float f32x4 __attribute__((ext_vector_type(4)));
typedef unsigned u32x4 __attribute__((ext_vector_type(4)));
constexpr int BM = 256, BK = 64, HALF = 128, HTB = HALF * BK * 2  , STAGE_BYTES = 8 * HTB, NXCD = 8, WGM = 8;

__host__ __device__ __forceinline__ int lds_byte(int r, int c) { const int st = (r >> 4) * 2 + (c >> 5), rr = r & 15, cc = c & 31, ob = rr * 64 + cc * 2; return st * 1024 + (ob ^ (((ob >> 9) & 1) << 5)); }
__host__ __device__ __forceinline__ void stage_rc(int b, int& R, int& C) { const int st = b / 1024, sb = b % 1024, swz = sb ^ (((sb >> 9) & 1) << 5); R = (st >> 1) * 16 + swz / 64; C = (st & 1) * 32 + (swz % 64) / 2; }
__host__ __device__ __forceinline__ int perm32(int rho) { const int n = rho >> 4, i = rho & 15; return 8 * (i >> 2) + 4 * n + (i & 3); }

struct Unit { int pm, pn; };
struct Gemm { const bf16_t* A; const bf16_t* Bt; int M, N, K; };

struct StaticOrder {
    int nM, nN, nwg, G, c;
    __host__ __device__ void init(int M, int N, int G_, int c_) { nM = M / BM; nN = N / BM; nwg = nM * nN; G = G_; c = c_; }
    __host__ __device__ bool next(int i, Unit& u) const {
        const long L = (long)i * G + c; if (L >= nwg) return false;
        int wgid = (int)L; { const int q = nwg / NXCD, r = nwg % NXCD, xcd = wgid % NXCD, off = wgid / NXCD; wgid = (xcd < r ? xcd * (q + 1) : r * (q + 1) + (xcd - r) * q) + off; }
        const int nig = WGM * nN, gid = wgid / nig, fm = gid * WGM, gsz = (nM - fm) < WGM ? (nM - fm) : WGM;
        u.pm = fm + ((wgid % nig) % gsz); u.pn = (wgid % nig) / gsz; return true;
    }
    __device__ __forceinline__ void a_ready(const Unit&) const {}
    __device__ __forceinline__ void done(const Unit&) const {}
};

__device__ __forceinline__ unsigned cvt_pk_bf16(float lo, float hi) { unsigned r; asm volatile("v_cvt_pk_bf16_f32 %0, %1, %2" : "=v"(r) : "v"(lo), "v"(hi)); return r; }
typedef float f32x2 __attribute__((ext_vector_type(2)));
__device__ __forceinline__ f32x2 gelu_pk(f32x2 v) {
    const f32x2 av = __builtin_elementwise_abs(v), d = av * 0.2316418882f + 1.0f;
    f32x2 t; t.x = __builtin_amdgcn_rcpf(d.x); t.y = __builtin_amdgcn_rcpf(d.y);
    f32x2 q = t * 0.5307027145f + (-0.7265760135f); q = q * t + 0.7107068705f; q = q * t + (-0.142248368f); q = q * t + 0.127414796f; q = q * t;
    const f32x2 s = (v * v) * (-0.72134752044f);
    f32x2 e; e.x = __builtin_amdgcn_exp2f(s.x); e.y = __builtin_amdgcn_exp2f(s.y);
    const f32x2 m = v * (q * e), r = v - m;
    f32x2 o; o.x = v.x < 0.f ? m.x : r.x; o.y = v.y < 0.f ? m.y : r.y; return o;
}

constexpr float NORM_EPS_ = 1e-6f;
__device__ __forceinline__ u32x4 pack8(f32x4 a, f32x4 b) { u32x4 w; w.x = cvt_pk_bf16(a[0], a[1]); w.y = cvt_pk_bf16(a[2], a[3]); w.z = cvt_pk_bf16(b[0], b[1]); w.w = cvt_pk_bf16(b[2], b[3]); return w; }
__device__ __forceinline__ float rstd8(const float* ss) { const f32x4 a = *(const f32x4*)ss, b = *(const f32x4*)(ss + 4); return 1.0f / sqrtf((((a[0] + a[1]) + (a[2] + a[3])) + ((b[0] + b[1]) + (b[2] + b[3]))) * (1.0f / 2048.0f) + NORM_EPS_); }
__device__ __forceinline__ float bf_lo(unsigned w) { return __uint_as_float(w << 16); }
__device__ __forceinline__ float bf_hi(unsigned w) { return __uint_as_float(w & 0xffff0000u); }

struct EpiIn {
    static constexpr bool PERM = true, AFTER_DRAIN = false;
    const float* rstd; bf16_t* QB; bf16_t* KB; bf16_t* VB; float* US; float* Kout; float* Vout; float qscale;
    __device__ __forceinline__ void operator()(const f32x4 (&acc)[2][2][4][2], const Unit& u, int wr, int wc, int fr, int fq) const {
        { int t_ = threadIdx.x; asm volatile("" : "+v"(t_)); fr = t_ & 15; fq = (t_ >> 4) & 3; }
        const int row0 = u.pm * BM + wr * 64 + fr, sec = u.pn >> 2, col0 = (u.pn & 3) * BM + wc * 32 + 8 * fq;
#pragma unroll
        for (int ai = 0; ai < 2; ++ai)
#pragma unroll
            for (int m = 0; m < 4; ++m) { const int row = row0 + ai * HALF + m * 16; const float rs = rstd[row]; const size_t o = (size_t)row * 1024 + col0;
#pragma unroll
                for (int bj = 0; bj < 2; ++bj) { f32x4 v0 = acc[ai][bj][m][0] * rs, v1 = acc[ai][bj][m][1] * rs; const size_t oo = o + bj * HALF;
                    if (sec == 0) { v0 = v0 * qscale; v1 = v1 * qscale; *(u32x4*)(QB + oo) = pack8(v0, v1); }
                    else if (sec == 1) { *(f32x4*)(Kout + oo) = v0; *(f32x4*)(Kout + oo + 4) = v1; *(u32x4*)(KB + oo) = pack8(v0, v1); }
                    else if (sec == 2) { *(f32x4*)(Vout + oo) = v0; *(f32x4*)(Vout + oo + 4) = v1; *(u32x4*)(VB + oo) = pack8(v0, v1); }
                    else { *(f32x4*)(US + oo) = v0; *(f32x4*)(US + oo + 4) = v1; } } }
    }
};
struct EpiPlain {
    static constexpr bool PERM = true, AFTER_DRAIN = false;
    bf16_t* O; int ldc;
    __device__ __forceinline__ void operator()(const f32x4 (&acc)[2][2][4][2], const Unit& u, int wr, int wc, int fr, int fq) const {
        { int t_ = threadIdx.x; asm volatile("" : "+v"(t_)); fr = t_ & 15; fq = (t_ >> 4) & 3; }
        const int row0 = u.pm * BM + wr * 64 + fr, col0 = u.pn * BM + wc * 32 + 8 * fq;
#pragma unroll
        for (int ai = 0; ai < 2; ++ai)
#pragma unroll
            for (int m = 0; m < 4; ++m) { bf16_t* rowp = O + (size_t)(row0 + ai * HALF + m * 16) * ldc + col0;
#pragma unroll
                for (int bj = 0; bj < 2; ++bj) *(u32x4*)(rowp + bj * HALF) = pack8(acc[ai][bj][m][0], acc[ai][bj][m][1]); }
    }
};
template <int CTRL> __device__ __forceinline__ float dppf_(float x) { return __builtin_bit_cast(float, __builtin_amdgcn_update_dpp(0, __builtin_bit_cast(int, x), CTRL, 0xf, 0xf, true)); }
struct EpiUpConv {
    static constexpr bool PERM = true, AFTER_DRAIN = false;
    const float* ssin; bf16_t* HFF; float* conv_out; const float* cw; const float* cb; float* GF; float* VF; float* GL; PG8_LAS float* HAL; int ldf;
    __device__ __forceinline__ void operator()(const f32x4 (&acc)[2][2][4][2], const Unit& u, int wr, int wc, int fr, int fq) const {
        { int t_ = threadIdx.x; asm volatile("" : "+v"(t_)); fr = t_ & 15; fq = (t_ >> 4) & 3; }
        const int row0 = u.pm * BM + wr * 64 + fr, col0 = u.pn * HALF + wc * 32 + 8 * fq;
        float w0[8], w1[8], w2[8], cbv[8];
#pragma unroll
        for (int h = 0; h < 2; ++h) { const f32x4 a = *(const f32x4*)(cw + col0 + 4 * h), b = *(const f32x4*)(cw + ldf + col0 + 4 * h), c = *(const f32x4*)(cw + 2 * ldf + col0 + 4 * h), d = *(const f32x4*)(cb + col0 + 4 * h);
#pragma unroll
            for (int e = 0; e < 4; ++e) { w0[4 * h + e] = a[e]; w1[4 * h + e] = b[e]; w2[4 * h + e] = c[e]; cbv[4 * h + e] = d[e]; } }
        float rsl[2];
#pragma unroll
        for (int ai = 0; ai < 2; ++ai) { rsl[ai] = rstd8(ssin + (size_t)(row0 + ai * HALF + 48) * 8);
            if (fr >= 14) { PG8_LAS float* dst = HAL + ((((wr * 4 + wc) * 2 + ai) * 2 + (fr - 14)) * 32 + 8 * fq);
                *(PG8_LAS f32x4*)dst = acc[ai][0][3][0] * rsl[ai]; *(PG8_LAS f32x4*)(dst + 4) = acc[ai][0][3][1] * rsl[ai]; } }
        asm volatile("s_waitcnt lgkmcnt(0)" ::: "memory"); __builtin_amdgcn_s_barrier(); asm volatile("" ::: "memory");
#pragma unroll
        for (int ai = 0; ai < 2; ++ai) {
            float pg[8];
            float h1[8], h2[8];
            { const int swr = wr == 1 ? 0 : 1, sai = wr == 1 ? ai : 0; const bool have = (wr == 1) || (ai == 1);
              const PG8_LAS float* src = HAL + ((((swr * 4 + wc) * 2 + sai) * 2) * 32 + 8 * fq);
#pragma unroll
              for (int e = 0; e < 8; ++e) { h2[e] = have ? src[e] : 0.f; h1[e] = have ? src[32 + e] : 0.f; } }
#pragma unroll
            for (int m = 0; m < 4; ++m) { const int row = row0 + ai * HALF + m * 16; const float rs = (m == 3) ? rsl[ai] : rstd8(ssin + (size_t)row * 8); const size_t o = (size_t)row * ldf + col0;
                float g[8], v[8], hh[8];
#pragma unroll
                for (int e = 0; e < 4; ++e) { g[e] = acc[ai][0][m][0][e] * rs; g[4 + e] = acc[ai][0][m][1][e] * rs; v[e] = acc[ai][1][m][0][e] * rs; v[4 + e] = acc[ai][1][m][1][e] * rs; }
#pragma unroll
                for (int e = 0; e < 8; ++e) {
                    const float c1 = dppf_<0x121>(g[e]), c2 = dppf_<0x122>(g[e]);
                    float p1, p2;
                    if (m == 0) { p1 = h1[e]; p2 = fr == 0 ? h2[e] : h1[e]; }
                    else { p1 = dppf_<0x121>(pg[e]); p2 = dppf_<0x122>(pg[e]); }
                    const float g1 = fr >= 1 ? c1 : p1, g2 = fr >= 2 ? c2 : p2;
                    const float cv = cbv[e] + w0[e] * g2 + w1[e] * g1 + w2[e] * g[e];
                    hh[e] = cv * __builtin_amdgcn_rcpf(1.f + __builtin_amdgcn_exp2f(-1.4426950408889634f * cv)) * v[e]; }
                u32x4 w; w.x = cvt_pk_bf16(hh[0], hh[1]); w.y = cvt_pk_bf16(hh[2], hh[3]); w.z = cvt_pk_bf16(hh[4], hh[5]); w.w = cvt_pk_bf16(hh[6], hh[7]);
                *(u32x4*)(HFF + o) = w;
                const int rl = ai * HALF + wr * 64 + m * 16 + fr, tt = row & 4095;
                if (rl < 2) { float* gf = GF + (size_t)(u.pm * 2 + rl) * ldf + col0; float* vf = VF + (size_t)(u.pm * 2 + rl) * ldf + col0;
                    *(f32x4*)gf = (f32x4){g[0], g[1], g[2], g[3]}; *(f32x4*)(gf + 4) = (f32x4){g[4], g[5], g[6], g[7]}; *(f32x4*)vf = (f32x4){v[0], v[1], v[2], v[3]}; *(f32x4*)(vf + 4) = (f32x4){v[4], v[5], v[6], v[7]}; }
                if (rl >= 254) { float* gl = GL + (size_t)(u.pm * 2 + rl - 254) * ldf + col0; *(f32x4*)gl = (f32x4){g[0], g[1], g[2], g[3]}; *(f32x4*)(gl + 4) = (f32x4){g[4], g[5], g[6], g[7]}; }
                if (tt >= 4094) { float* co = conv_out + (size_t)((row >> 12) * 2 + (tt - 4094)) * ldf + col0; *(f32x4*)co = (f32x4){g[0], g[1], g[2], g[3]}; *(f32x4*)(co + 4) = (f32x4){g[4], g[5], g[6], g[7]}; }
#pragma unroll
                for (int e = 0; e < 8; ++e) pg[e] = g[e];
            }
        }
    }
};
template <int MODE> struct EpiRes {
    static constexpr bool PERM = true, AFTER_DRAIN = true;
    const float* base; float* outf; bf16_t* outb; float* ss; const float* ssin; const bf16_t* proj;
    __device__ __forceinline__ void fused(f32x4 (&acc)[2][2][4][2], const Unit& u, int wr, int wc, int fr, int fq, PG8_LAS unsigned char* lds, int wid, int lane) const {
        { int t_ = threadIdx.x; asm volatile("" : "+v"(t_)); fr = t_ & 15; fq = (t_ >> 4) & 3; }
        PG8_LAS float* P = (PG8_LAS float*)lds;
        const int col0 = u.pn * BM + wc * 32 + 8 * fq;
#pragma unroll
        for (int ai = 0; ai < 2; ++ai)
#pragma unroll
            for (int m = 0; m < 4; ++m) { const int rl = ai * HALF + wr * 64 + m * 16 + fr, row = u.pm * BM + rl; const size_t o = (size_t)row * 2048 + col0;
                float rs = 1.f; if (MODE == 1) rs = rstd8(ssin + (size_t)row * 8);
                float sq = 0.f;
#pragma unroll
                for (int bj = 0; bj < 2; ++bj) { const size_t oo = o + bj * HALF; f32x4 a0 = acc[ai][bj][m][0], a1 = acc[ai][bj][m][1];
                    const f32x4 b0 = *(const f32x4*)(base + oo), b1 = *(const f32x4*)(base + oo + 4);
                    if (MODE == 1) { const u32x4 pw = *(const u32x4*)(proj + oo);
                        const f32x4 p0 = {bf_lo(pw.x), bf_hi(pw.x), bf_lo(pw.y), bf_hi(pw.y)}, p1 = {bf_lo(pw.z), bf_hi(pw.z), bf_lo(pw.w), bf_hi(pw.w)};
#pragma unroll
                        for (int e = 0; e < 4; ++e) { a0[e] = p0[e] * __builtin_amdgcn_rcpf(1.f + __builtin_amdgcn_exp2f(-1.4426950408889634f * rs * a0[e])); a1[e] = p1[e] * __builtin_amdgcn_rcpf(1.f + __builtin_amdgcn_exp2f(-1.4426950408889634f * rs * a1[e])); } }
                    const f32x4 h0 = b0 + a0, h1 = b1 + a1;
                    *(f32x4*)(outf + oo) = h0; *(f32x4*)(outf + oo + 4) = h1;
                    if (outb) *(u32x4*)(outb + oo) = pack8(h0, h1);
                    sq += (h0[0] * h0[0] + h0[1] * h0[1]) + (h0[2] * h0[2] + h0[3] * h0[3]) + (h1[0] * h1[0] + h1[1] * h1[1]) + (h1[2] * h1[2] + h1[3] * h1[3]); }
                sq += __shfl_xor(sq, 16); sq += __shfl_xor(sq, 32);
                if (fq == 0) P[rl * 4 + wc] = sq; }
        asm volatile("s_waitcnt lgkmcnt(0)" ::: "memory"); __builtin_amdgcn_s_barrier(); asm volatile("" ::: "memory");
        const int t = wid * 64 + lane;
        if (t < 256) { const f32x4 p = *(const PG8_LAS f32x4*)(P + t * 4); ss[(size_t)(u.pm * BM + t) * 8 + u.pn] = (p[0] + p[1]) + (p[2] + p[3]); }
        asm volatile("s_waitcnt lgkmcnt(0)" ::: "memory"); __builtin_amdgcn_s_barrier(); asm volatile("" ::: "memory");
    }
};
template <class Epi, class Sched, bool ALIGN_EPI = false, bool SP2 = false>
__device__ __forceinline__ void gemm_phase(PG8_LAS unsigned char* lds, const Gemm g, const Sched& S, const Epi& E) {
    int tid_o = threadIdx.x; asm volatile("" : "+v"(tid_o));
    const int tid = tid_o, wid = __builtin_amdgcn_readfirstlane(tid >> 6), lane = tid & 63, wr = wid >> 2, wc = wid & 3, fr = lane & 15, fq = lane >> 4;
    const int K = g.K, nt = K / BK;
    unsigned voffA[2], voffB[2];
#pragma unroll
    for (int i = 0; i < 2; ++i) { int R, C; stage_rc(tid * 16 + i * 8192, R, C); const int Rb = Epi::PERM ? ((R & ~31) + perm32(R & 31)) : R;
        voffA[i] = (unsigned)(R * K + C) * 2u; voffB[i] = (unsigned)(Rb * K + C) * 2u; }
    const size_t kstep = (size_t)(BK * 2);
    const size_t hstep = (size_t)HALF * K * 2;
    const size_t tstep = 2 * hstep;
    const unsigned ldsw = (unsigned)wid * 1024u;
    const int aoff = lds_byte(wr * 64 + fr, fq * 8), boff = lds_byte(wc * 32 + fr, fq * 8);
#define PG8_SA(b, h) (((b) * 2 + (h)) * HTB)
#define PG8_SB(b, h) ((4 + (b) * 2 + (h)) * HTB)
#define PG8_STAGE(bufoff, gbase, voff) do { _Pragma("unroll") for (int _i = 0; _i < 2; ++_i) \
        __builtin_amdgcn_global_load_lds((const unsigned*)((const char*)(gbase) + (voff)[_i]), (PG8_LAS unsigned*)(lds + (bufoff) + ldsw + _i * 8192), 16, 0, 0); } while (0)
#define PG8_LDA(dst, b, h) do { _Pragma("unroll") for (int m = 0; m < 4; ++m) _Pragma("unroll") for (int k = 0; k < 2; ++k) dst[m][k] = *(const PG8_LAS bf16x8*)(lds + PG8_SA(b, h) + aoff + m * 2048 + k * 1024); } while (0)
#define PG8_LDB(dst, b, h) do { _Pragma("unroll") for (int n = 0; n < 2; ++n) _Pragma("unroll") for (int k = 0; k < 2; ++k) dst[n][k] = *(const PG8_LAS bf16x8*)(lds + PG8_SB(b, h) + boff + n * 2048 + k * 1024); } while (0)
#define PG8_MMA(ai, bj, At, Bt) do { __builtin_amdgcn_s_setprio(1); _Pragma("unroll") for (int m = 0; m < 4; ++m) _Pragma("unroll") for (int n = 0; n < 2; ++n) _Pragma("unroll") for (int k = 0; k < 2; ++k) \
        acc[ai][bj][m][n] = __builtin_amdgcn_mfma_f32_16x16x32_bf16(Bt[n][k], At[m][k], acc[ai][bj][m][n], 0, 0, 0); __builtin_amdgcn_s_setprio(0); } while (0)
#define PG8_WAIT_V(n) asm volatile("s_waitcnt vmcnt(" #n ")" ::: "memory")
#define PG8_WAIT_L(n) asm volatile("s_waitcnt lgkmcnt(" #n ")" ::: "memory")
#define PG8_BAR __builtin_amdgcn_s_barrier()
#define PG8_SCHED __builtin_amdgcn_sched_barrier(0)
    Unit cur, nxt; int ui = 0;
    if (!S.next(0, cur)) return;
    f32x4 acc[2][2][4][2];
#pragma unroll
    for (int a = 0; a < 2; ++a)
#pragma unroll
        for (int b = 0; b < 2; ++b)
#pragma unroll
            for (int m = 0; m < 4; ++m)
#pragma unroll
                for (int n = 0; n < 2; ++n) acc[a][b][m][n] = (f32x4){0.f, 0.f, 0.f, 0.f};
    bf16x8 At[4][2], B0[2][2], B1[2][2];
    const char* cA = (const char*)g.A + (size_t)cur.pm * tstep; const char* cB = (const char*)g.Bt + (size_t)cur.pn * tstep;
    S.a_ready(cur);
    if constexpr (SP2) {
        PG8_STAGE(PG8_SB(0, 0), cB, voffB); PG8_STAGE(PG8_SB(0, 1), cB + hstep, voffB); PG8_STAGE(PG8_SA(0, 0), cA, voffA); PG8_STAGE(PG8_SA(0, 1), cA + hstep, voffA);
        if (wr == 1) PG8_BAR;
        PG8_WAIT_V(2); PG8_BAR;
        PG8_STAGE(PG8_SB(1, 0), cB + kstep, voffB); PG8_STAGE(PG8_SA(1, 0), cA + kstep, voffA); PG8_STAGE(PG8_SB(1, 1), cB + hstep + kstep, voffB);
        PG8_WAIT_V(6); PG8_BAR;
    } else {
        PG8_STAGE(PG8_SB(0, 0), cB, voffB); PG8_STAGE(PG8_SA(0, 0), cA, voffA); PG8_STAGE(PG8_SB(0, 1), cB + hstep, voffB); PG8_STAGE(PG8_SA(0, 1), cA + hstep, voffA);
        if (wr == 1) PG8_BAR;
        PG8_WAIT_V(4); PG8_BAR;
        PG8_STAGE(PG8_SB(1, 0), cB + kstep, voffB); PG8_STAGE(PG8_SA(1, 0), cA + kstep, voffA); PG8_STAGE(PG8_SB(1, 1), cB + hstep + kstep, voffB);
        PG8_WAIT_V(6); PG8_BAR;
    }
    for (;;) {
        const bool has_next = S.next(ui + 1, nxt);
        const char* nA = has_next ? (const char*)g.A + (size_t)nxt.pm * tstep : cA; const char* nB = has_next ? (const char*)g.Bt + (size_t)nxt.pn * tstep : cB;
        for (int t = 0; t < nt; t += 2) {
            const bool last = (t == nt - 2);
            const char* a1 = cA + (size_t)(t + 1) * kstep;
            const char* a2 = last ? nA : cA + (size_t)(t + 2) * kstep; const char* b2 = last ? nB : cB + (size_t)(t + 2) * kstep;
            const char* a3 = a2 + kstep; const char* b3 = b2 + kstep;
            if (last && has_next) S.a_ready(nxt);
            if constexpr (SP2) {
            PG8_LDB(B0, 0, 0); PG8_LDB(B1, 0, 1); PG8_SCHED; PG8_LDA(At, 0, 0); PG8_STAGE(PG8_SA(1, 1), a1 + hstep, voffA);
            PG8_WAIT_V(8); PG8_WAIT_L(0); PG8_BAR; PG8_MMA(0, 0, At, B0); PG8_MMA(0, 1, At, B1); PG8_BAR; PG8_SCHED;
            PG8_LDA(At, 0, 1); PG8_STAGE(PG8_SB(0, 0), b2, voffB); PG8_STAGE(PG8_SB(0, 1), b2 + hstep, voffB); PG8_STAGE(PG8_SA(0, 0), a2, voffA);
            PG8_WAIT_V(8); PG8_WAIT_L(0); PG8_BAR; PG8_MMA(1, 0, At, B0); PG8_MMA(1, 1, At, B1); PG8_BAR; PG8_SCHED;
            PG8_LDB(B0, 1, 0); PG8_LDB(B1, 1, 1); PG8_SCHED; PG8_LDA(At, 1, 0); PG8_STAGE(PG8_SA(0, 1), a2 + hstep, voffA);
            PG8_WAIT_V(8); PG8_WAIT_L(0); PG8_BAR; PG8_MMA(0, 0, At, B0); PG8_MMA(0, 1, At, B1); PG8_BAR; PG8_SCHED;
            PG8_LDA(At, 1, 1); PG8_STAGE(PG8_SB(1, 0), b3, voffB); PG8_STAGE(PG8_SB(1, 1), b3 + hstep, voffB); PG8_STAGE(PG8_SA(1, 0), a3, voffA);
            PG8_WAIT_V(8); PG8_WAIT_L(0); PG8_BAR; PG8_MMA(1, 0, At, B0); PG8_MMA(1, 1, At, B1); PG8_BAR; PG8_SCHED;
            } else {
            PG8_LDB(B0, 0, 0); PG8_SCHED; PG8_LDA(At, 0, 0); PG8_STAGE(PG8_SA(1, 1), a1 + hstep, voffA);
            PG8_WAIT_L(8); PG8_BAR; PG8_WAIT_L(0); PG8_MMA(0, 0, At, B0); PG8_BAR; PG8_SCHED;
            PG8_LDB(B1, 0, 1); PG8_STAGE(PG8_SB(0, 0), b2, voffB);
            PG8_BAR; PG8_WAIT_L(0); PG8_MMA(0, 1, At, B1); PG8_BAR;
            PG8_LDA(At, 0, 1); PG8_STAGE(PG8_SA(0, 0), a2, voffA);
            PG8_BAR; PG8_WAIT_L(0); PG8_MMA(1, 0, At, B0); PG8_BAR; PG8_SCHED;
            PG8_STAGE(PG8_SB(0, 1), b2 + hstep, voffB);
            PG8_WAIT_V(6); PG8_BAR; PG8_MMA(1, 1, At, B1); PG8_BAR;
            PG8_LDB(B0, 1, 0); PG8_SCHED; PG8_LDA(At, 1, 0); PG8_STAGE(PG8_SA(0, 1), a2 + hstep, voffA);
            PG8_WAIT_L(8); PG8_BAR; PG8_WAIT_L(0); PG8_MMA(0, 0, At, B0); PG8_BAR; PG8_SCHED;
            PG8_LDB(B1, 1, 1); PG8_STAGE(PG8_SB(1, 0), b3, voffB);
            PG8_BAR; PG8_WAIT_L(0); PG8_MMA(0, 1, At, B1); PG8_BAR;
            PG8_LDA(At, 1, 1); PG8_STAGE(PG8_SA(1, 0), a3, voffA);
            PG8_BAR; PG8_WAIT_L(0); PG8_MMA(1, 0, At, B0); PG8_BAR; PG8_SCHED;
            PG8_STAGE(PG8_SB(1, 1), b3 + hstep, voffB);
            PG8_WAIT_V(6); PG8_BAR; PG8_MMA(1, 1, At, B1); PG8_BAR;
            }
        }
        if constexpr (ALIGN_EPI) { if (wr == 0) PG8_BAR; }
        if constexpr (!Epi::AFTER_DRAIN) { E(acc, cur, wr, wc, fr, fq); S.done(cur); }
        if (!has_next) break;
#pragma unroll
        for (int a = 0; a < 2; ++a)
#pragma unroll
            for (int b = 0; b < 2; ++b)
#pragma unroll
                for (int m = 0; m < 4; ++m)
#pragma unroll
                    for (int n = 0; n < 2; ++n) acc[a][b][m][n] = (f32x4){0.f, 0.f, 0.f, 0.f};
        cur = nxt; cA = nA; cB = nB; ++ui;
        if constexpr (ALIGN_EPI) { if (wr == 1) PG8_BAR; }
    }
    PG8_WAIT_V(0);
    if constexpr (!ALIGN_EPI) { if (wr == 0) PG8_BAR; }
    PG8_BAR;
    if constexpr (Epi::AFTER_DRAIN) { E.fused(acc, cur, wr, wc, fr, fq, lds, wid, lane); S.done(cur); }
#undef PG8_SA
#undef PG8_SB
#undef PG8_STAGE
#undef PG8_LDA
#undef PG8_LDB
#undef PG8_MMA
#undef PG8_WAIT_V
#undef PG8_WAIT_L
#undef PG8_BAR
#undef PG8_SCHED
}
}
namespace attn_body {
using bf16=__hip_bfloat16;
using bf16x8=__attribute__((ext_vector_type(8)))short;
using s16x4=__attribute__((ext_vector_type(4)))short;
using f32x16=__attribute__((ext_vector_type(16)))float;
using u32x4=__attribute__((ext_vector_type(4)))unsigned;
constexpr int BATCH=2,NHEAD=16,SEQ=4096,D=64,DM=NHEAD*D;
constexpr int NW=8,QBLK=32,QB=QBLK*NW,KVBLK=64,NQB=SEQ/QB;
constexpr int ATTN_PITCH=DM, ATTN_UNIT_ROWS=QB;
__device__ __forceinline__ int crow(int r,int hi){return (r&3)+8*(r>>2)+4*hi;}
#define SBAR() __builtin_amdgcn_sched_barrier(0)
__device__ __forceinline__ void cmask(f32x16&p0,f32x16&p1,int jb,int qrel,int hi){
  const float NEG=-INFINITY; int kb=64*jb+4*hi;
  #pragma unroll
  for(int r=0;r<16;++r){int kv=kb+(r&3)+8*(r>>2); if(kv>qrel)p0[r]=NEG; if(kv+32>qrel)p1[r]=NEG;}
}

typedef __attribute__((address_space(3))) const float* lds_cfptr;
__device__ __forceinline__ void bmask(f32x16&p0,f32x16&p1,int t,int qabs,int hi,lds_cfptr lutx){
  const unsigned pa=(unsigned)(unsigned long long)(lutx+(qabs-64*t-4*hi+256-59));
  #define BM_LD(V,R,OFF) asm volatile("ds_read_b32 %0, %1 offset:%c2":"=v"(V):"v"(pa),"i"(4*(59-(OFF)-((R)&3)-8*((R)>>2))):"memory")
  #define BM_AD(P,R,V) asm volatile("v_add_f32 %0, %0, %1":"+v"(P[R]):"v"(V))
  #define BM_GRP(P,R0,OFF) do{ float v0_,v1_,v2_,v3_,v4_,v5_,v6_,v7_; \
    BM_LD(v0_,(R0)+0,OFF); BM_LD(v1_,(R0)+1,OFF); BM_LD(v2_,(R0)+2,OFF); BM_LD(v3_,(R0)+3,OFF); BM_LD(v4_,(R0)+4,OFF); BM_LD(v5_,(R0)+5,OFF); BM_LD(v6_,(R0)+6,OFF); BM_LD(v7_,(R0)+7,OFF); \
    asm volatile("s_waitcnt lgkmcnt(0)":"+v"(v0_),"+v"(v1_),"+v"(v2_),"+v"(v3_),"+v"(v4_),"+v"(v5_),"+v"(v6_),"+v"(v7_)::"memory"); \
    BM_AD(P,(R0)+0,v0_); BM_AD(P,(R0)+1,v1_); BM_AD(P,(R0)+2,v2_); BM_AD(P,(R0)+3,v3_); BM_AD(P,(R0)+4,v4_); BM_AD(P,(R0)+5,v5_); BM_AD(P,(R0)+6,v6_); BM_AD(P,(R0)+7,v7_); }while(0)
  BM_GRP(p0,0,0); BM_GRP(p0,8,0); BM_GRP(p1,0,32); BM_GRP(p1,8,32);
  #undef BM_GRP
  #undef BM_LD
  #undef BM_AD
}
constexpr int NSLOT=3, SLOTB=8192;
constexpr int LDS_K=0, LDS_V=NSLOT*SLOTB, LDS_WS=2*NSLOT*SLOTB, LDS_OST=LDS_WS+NW*64*4, LDS_BYTES=LDS_OST+NW*4096;
constexpr float C2=0.125f*1.4426950408889634f;
__device__ __forceinline__ void glds16(const void*gsrc,unsigned lds_dst){unsigned keep;
  asm volatile("s_mov_b32 %0, m0\n\ts_mov_b32 m0, %2\n\ts_nop 0\n\tglobal_load_lds_dwordx4 %1, off\n\ts_mov_b32 m0, %0":"=&s"(keep):"v"(gsrc),"s"(lds_dst):"memory");}
__device__ __forceinline__ float max3f(float a,float b,float c){float r;asm("v_max3_f32 %0, %1, %2, %3":"=v"(r):"v"(a),"v"(b),"v"(c));return r;}
__device__ __forceinline__ float max2f(float a,float b){float r;asm("v_max_f32_e32 %0, %1, %2":"=v"(r):"v"(a),"v"(b));return r;}
__device__ __forceinline__ float fadd_s(float a,float b){float r;asm("v_add_f32_e32 %0, %1, %2":"=v"(r):"v"(a),"v"(b));return r;}
__device__ __forceinline__ float fsub_s(float a,float b){float r;asm("v_sub_f32_e32 %0, %1, %2":"=v"(r):"v"(a),"v"(b));return r;}
typedef float f32x2_t __attribute__((ext_vector_type(2))); typedef __bf16 bf16x2_t __attribute__((ext_vector_type(2)));
__device__ __forceinline__ unsigned cvtpk_s(float lo,float hi){f32x2_t v={lo,hi};bf16x2_t b=__builtin_convertvector(v,bf16x2_t);return __builtin_bit_cast(unsigned,b);}
#define WAIT_BAR(N) asm volatile("s_waitcnt vmcnt(" #N ") lgkmcnt(0)\n\ts_barrier":::"memory")

__device__ __forceinline__ void qkt(f32x16&p0,f32x16&p1,const char*Kslot,const bf16x8*qr,const f32x16&negm,int r32,int hi){
  const char*kb=Kslot+hi*1024+r32*16;
  #pragma unroll
  for(int d0=0;d0<4;++d0){
    const bf16x8 b0=*reinterpret_cast<const bf16x8*>(kb+d0*2048);
    const bf16x8 b1=*reinterpret_cast<const bf16x8*>(kb+d0*2048+512);
    if(d0==0){p0=__builtin_amdgcn_mfma_f32_32x32x16_bf16(b0,qr[0],negm,0,0,0);p1=__builtin_amdgcn_mfma_f32_32x32x16_bf16(b1,qr[0],negm,0,0,0);}
    else{p0=__builtin_amdgcn_mfma_f32_32x32x16_bf16(b0,qr[d0],p0,0,0,0);p1=__builtin_amdgcn_mfma_f32_32x32x16_bf16(b1,qr[d0],p1,0,0,0);}}
}
typedef __attribute__((address_space(3))) const char* lds_cptr;
typedef short v4i16_t __attribute__((ext_vector_type(4)));
__device__ __forceinline__ void kload8(bf16x8*kf,lds_cptr kp){
  kf[0]=*(const __attribute__((address_space(3))) bf16x8*)(kp);      kf[1]=*(const __attribute__((address_space(3))) bf16x8*)(kp+512);
  kf[2]=*(const __attribute__((address_space(3))) bf16x8*)(kp+2048); kf[3]=*(const __attribute__((address_space(3))) bf16x8*)(kp+2560);
  kf[4]=*(const __attribute__((address_space(3))) bf16x8*)(kp+4096); kf[5]=*(const __attribute__((address_space(3))) bf16x8*)(kp+4608);
  kf[6]=*(const __attribute__((address_space(3))) bf16x8*)(kp+6144); kf[7]=*(const __attribute__((address_space(3))) bf16x8*)(kp+6656);
}
__device__ __forceinline__ void kload2(bf16x8*kf,lds_cptr kp,int j){ kf[2*j]=*(const __attribute__((address_space(3))) bf16x8*)(kp+j*2048); kf[2*j+1]=*(const __attribute__((address_space(3))) bf16x8*)(kp+j*2048+512); }
__device__ __forceinline__ s16x4 vtr(lds_cptr p){ return __builtin_bit_cast(s16x4,__builtin_amdgcn_ds_read_tr16_b64_v4i16((__attribute__((address_space(3))) v4i16_t*)p)); }
__device__ __forceinline__ float rowmax(const f32x16&p0,const f32x16&p1){
  float a=max3f(p0[0],p0[1],p1[0]),b=max3f(p0[2],p0[3],p1[1]);a=max3f(a,p1[2],p1[3]);
  #pragma unroll
  for(int r=4;r<16;r+=4){a=max3f(a,p0[r],p0[r+1]);b=max3f(b,p0[r+2],p0[r+3]);a=max3f(a,p1[r],p1[r+1]);b=max3f(b,p1[r+2],p1[r+3]);}
  const float m=max2f(a,b);
  auto rr=__builtin_amdgcn_permlane32_swap(__float_as_uint(m),__float_as_uint(m),false,false);
  return max2f(__uint_as_float(rr[0]),__uint_as_float(rr[1]));
}
__device__ __forceinline__ void pv(f32x16*o,int vb,bf16x8 pa0,bf16x8 pa1,bf16x8 pa2,bf16x8 pa3){
  #pragma unroll
  for(int d0=0;d0<2;++d0){s16x4 lo[4],hi[4];
    #pragma unroll
    for(int ks=0;ks<4;++ks){
      asm volatile("ds_read_b64_tr_b16 %0,%1 offset:%c2":"=&v"(lo[ks]):"v"(vb),"i"(d0*4096+ks*1024):"memory");
      asm volatile("ds_read_b64_tr_b16 %0,%1 offset:%c2":"=&v"(hi[ks]):"v"(vb),"i"(d0*4096+ks*1024+512):"memory");}
    asm volatile("s_waitcnt lgkmcnt(0)":::"memory");SBAR();
    #define PK(k) (bf16x8){lo[k][0],lo[k][1],lo[k][2],lo[k][3],hi[k][0],hi[k][1],hi[k][2],hi[k][3]}
    o[d0]=__builtin_amdgcn_mfma_f32_32x32x16_bf16(pa0,PK(0),o[d0],0,0,0);
    o[d0]=__builtin_amdgcn_mfma_f32_32x32x16_bf16(pa1,PK(1),o[d0],0,0,0);
    o[d0]=__builtin_amdgcn_mfma_f32_32x32x16_bf16(pa2,PK(2),o[d0],0,0,0);
    o[d0]=__builtin_amdgcn_mfma_f32_32x32x16_bf16(pa3,PK(3),o[d0],0,0,0);
    #undef PK
  }
}

#ifndef ATTN_STORE16
#define ATTN_STORE16(p,v) (*(u32x4*)(p)=(v))
#endif
template<int THRL> __device__ __forceinline__ void attn_unit(int b,int hq,int hv,int qb,const bf16*Q,const bf16*__restrict__ K,const bf16*__restrict__ V,bf16*O,char*shm,lds_cfptr lut){
  int tid_o=threadIdx.x; asm volatile("":"+v"(tid_o)); const int tid=tid_o,lane=tid&63,r32=lane&31,hi=lane>>5; const int wid=__builtin_amdgcn_readfirstlane(tid>>6);
  const long rowbase=(long)b*SEQ; const int q0=qb*QB;
  const bf16*Qw=Q+(rowbase+q0+wid*QBLK)*DM+hq*D;
  const bf16*Kh=K+rowbase*DM+hq*D,*Vh=V+rowbase*DM+hv*D;
  const unsigned lds0=(unsigned)(uintptr_t)shm;
  float*wsf=(float*)(shm+LDS_WS)+wid*64;
  const bf16*ksrc=Kh+(long)lane*DM+wid*8;
  const bf16*vsrc=Vh+(long)(16*(wid&3)+(lane>>2))*DM+(wid>>2)*32+(lane&3)*8;
  const unsigned kdst=lds0+LDS_K+wid*1024, vdst=lds0+LDS_V+wid*1024;
  #define DMA_K(t,slot) glds16(ksrc+(long)(t)*KVBLK*DM,(unsigned)__builtin_amdgcn_readfirstlane(kdst+(slot)))
  #define DMA_V(t,slot) glds16(vsrc+(long)(t)*KVBLK*DM,(unsigned)__builtin_amdgcn_readfirstlane(vdst+(slot)))
  const int vb0=(int)(lds0+LDS_V)+((lane>>4)&1)*32+(lane&3)*8+(4*hi+((lane&15)>>2))*64;
  const char*Kbase=shm+LDS_K; bf16x8 kf[8];
  const lds_cptr shm3=(lds_cptr)shm; const lds_cptr kp0=shm3+LDS_K+hi*1024+r32*16; const lds_cptr vp0=shm3+LDS_V+((lane>>4)&1)*32+(lane&3)*8+(4*hi+((lane&15)>>2))*64;
  const int NT=(q0+QB)/KVBLK;
  DMA_K(0,0);DMA_V(0,0);DMA_K(1,SLOTB);
  bf16x8 qr[4];
  #pragma unroll
  for(int d0=0;d0<4;++d0)qr[d0]=*reinterpret_cast<const bf16x8*>(&Qw[(long)r32*DM+d0*16+hi*8]);
  float mhat=0.f,l_reg=0.f;f32x16 o[2];o[0]=f32x16{};o[1]=f32x16{};f32x16 negm=f32x16{};asm volatile("":"+v"(negm));
  const int qrel=wid*QBLK+r32;
  #define CMASK(P0,P1,t) do{ if((t)>=NT-6) bmask(P0,P1,(t),q0+qrel,hi,lut); }while(0)
  bool resc=false;
  #define START(P0,P1) do{ const float rm=rowmax(P0,P1); resc=false; \
    { const float dl=rm; mhat=fadd_s(mhat,dl); \
      _Pragma("unroll") for(int r=0;r<16;++r){P0[r]=fsub_s(P0[r],dl);P1[r]=fsub_s(P1[r],dl);} \
      _Pragma("unroll") for(int r=0;r<16;++r)negm[r]=-mhat; asm volatile("":"+v"(negm)); } \
    _Pragma("unroll") for(int r=0;r<16;++r)P0[r]=__builtin_amdgcn_exp2f(P0[r]); }while(0)
  #define RESC() do{ if(resc){ asm volatile("s_waitcnt lgkmcnt(0)":::"memory"); \
      _Pragma("unroll") for(int d_=0;d_<2;++d_) _Pragma("unroll") for(int r=0;r<16;++r)o[d_][r]*=wsf[crow(r,hi)]; } }while(0)
  f32x16 pA0,pA1,pB0,pB1;
  int sl_prev=0,sl_cur=0,sl_next=SLOTB;
  #define ROT() do{sl_prev=sl_cur;sl_cur=sl_next;sl_next=(sl_next==(NSLOT-1)*SLOTB)?0:sl_next+SLOTB;}while(0)
  DMA_K(2,2*SLOTB);
  WAIT_BAR(3);
  qkt(pA0,pA1,Kbase,qr,negm,r32,hi);asm volatile("s_nop 15\n\ts_nop 7":"+v"(pA0),"+v"(pA1));CMASK(pA0,pA1,0);
  START(pA0,pA1);
  _Pragma("unroll") for(int r=0;r<16;++r)pA1[r]=__builtin_amdgcn_exp2f(pA1[r]);
  WAIT_BAR(0);
  DMA_K(3,0);DMA_V(1,SLOTB);
  ROT();
  kload8(kf,kp0+sl_cur);
  WAIT_BAR(2);
  s16x4 vlo[8],vhi[8]; u32x4 pw0,pw1,pw2,pw3;
  #define PKW(P,B) cvtpk_s(P[B],P[B+1])
  #define PAF(k) __builtin_bit_cast(bf16x8,pw##k)
  #define VFR(i) (bf16x8){vlo[i][0],vlo[i][1],vlo[i][2],vlo[i][3],vhi[i][0],vhi[i][1],vhi[i][2],vhi[i][3]}
  #define PIN(x) asm volatile("":"+v"(x))
  #define MX3(a,b,c) __builtin_fmaxf(__builtin_fmaxf((a),(b)),(c))
  #define GAPA(MF,A0,A1,A2,A3,W0,W1,PW) do{ MF; sacc+=A0; sacc+=A1; sacc+=A2; sacc+=A3; PIN(sacc); W0; W1; PIN(PW); SBAR(); }while(0)
  #define EX(v) __builtin_amdgcn_exp2f(v)
  #define GAPB(MF,X,B) do{ MF; X[B]=EX(X[B]); X[B+1]=EX(X[B+1]); X[B+2]=EX(X[B+2]); X[B+3]=EX(X[B+3]); PIN(X); SBAR(); }while(0)
  #define VRD(i) do{ vlo[i]=vtr(vp_+(((i)>>2)*4096+((i)&3)*1024)); vhi[i]=vtr(vp_+(((i)>>2)*4096+((i)&3)*1024+512)); }while(0)
  #define KRD(G,j) do{ if(G){ kload2(kf,kp0+sl_next,j); SBAR(); } }while(0)
  #define STEP(C0,C1,P0,P1,t,GK,GV,GL) do{ SBAR(); \
    const lds_cptr vp_=vp0+sl_prev; \
    VRD(0); SBAR(); float sacc=(P0[0]+P0[1]); \
    GAPA(C0=__builtin_amdgcn_mfma_f32_32x32x16_bf16(kf[0],qr[0],negm,0,0,0), P0[2],P0[3],P0[4],P0[5],     pw0[0]=PKW(P0,0), pw0[1]=PKW(P0,2), pw0); \
    VRD(4); SBAR(); GAPA(C1=__builtin_amdgcn_mfma_f32_32x32x16_bf16(kf[1],qr[0],negm,0,0,0), P0[6],P0[7],P0[8],P0[9],     pw0[2]=PKW(P0,4), pw0[3]=PKW(P0,6), pw0); \
    VRD(1); SBAR(); GAPA(C0=__builtin_amdgcn_mfma_f32_32x32x16_bf16(kf[2],qr[1],C0,0,0,0),   P0[10],P0[11],P0[12],P0[13], pw1[0]=PKW(P0,8), pw1[1]=PKW(P0,10), pw1); \
    VRD(5); SBAR(); GAPA(C1=__builtin_amdgcn_mfma_f32_32x32x16_bf16(kf[3],qr[1],C1,0,0,0),   P0[14],P0[15],P1[0],P1[1],   pw1[2]=PKW(P0,12),pw1[3]=PKW(P0,14), pw1); \
    VRD(2); SBAR(); GAPA(C0=__builtin_amdgcn_mfma_f32_32x32x16_bf16(kf[4],qr[2],C0,0,0,0),   P1[2],P1[3],P1[4],P1[5],     pw2[0]=PKW(P1,0), pw2[1]=PKW(P1,2), pw2); \
    VRD(6); SBAR(); GAPA(C1=__builtin_amdgcn_mfma_f32_32x32x16_bf16(kf[5],qr[2],C1,0,0,0),   P1[6],P1[7],P1[8],P1[9],     pw2[2]=PKW(P1,4), pw2[3]=PKW(P1,6), pw2); \
    VRD(3); SBAR(); GAPA(C0=__builtin_amdgcn_mfma_f32_32x32x16_bf16(kf[6],qr[3],C0,0,0,0),   P1[10],P1[11],P1[12],P1[13], pw3[0]=PKW(P1,8), pw3[1]=PKW(P1,10), pw3); \
    VRD(7); SBAR(); GAPA(C1=__builtin_amdgcn_mfma_f32_32x32x16_bf16(kf[7],qr[3],C1,0,0,0),   P1[14],P1[15],0.f,0.f,       pw3[2]=PKW(P1,12),pw3[3]=PKW(P1,14), pw3); \
    asm volatile("s_nop 15\n\ts_nop 7":"+v"(C0),"+v"(C1));   \
    l_reg+=sacc; \
    if(GK){DMA_K((t)+3,sl_cur);} if(GV){DMA_V((t)+1,sl_next);} \
    CMASK(C0,C1,t); \
    { float a=MX3(C0[0],C0[1],C1[0]),b=MX3(C0[2],C0[3],C1[1]); a=MX3(a,C1[2],C1[3]); \
      _Pragma("unroll") for(int r=4;r<16;r+=4){a=MX3(a,C0[r],C0[r+1]);b=MX3(b,C0[r+2],C0[r+3]);a=MX3(a,C1[r],C1[r+1]);b=MX3(b,C1[r+2],C1[r+3]);} \
      float rm=__builtin_fmaxf(a,b); { auto rr=__builtin_amdgcn_permlane32_swap(__float_as_uint(rm),__float_as_uint(rm),false,false); rm=__builtin_fmaxf(__uint_as_float(rr[0]),__uint_as_float(rr[1])); } \
      resc=false; \
      if(__builtin_expect(__any(rm>(float)THRL),0)){ const float dl=__builtin_fmaxf(rm,0.f); mhat+=dl; \
        _Pragma("unroll") for(int r=0;r<16;++r){C0[r]-=dl;C1[r]-=dl;} \
        _Pragma("unroll") for(int r=0;r<16;++r)negm[r]=-mhat; asm volatile("":"+v"(negm)); \
        const float f=__builtin_amdgcn_exp2f(-dl); l_reg*=f; if(hi==0)wsf[r32]=f; resc=true; } } \
    SBAR(); \
    GAPB(o[0]=__builtin_amdgcn_mfma_f32_32x32x16_bf16(PAF(0),VFR(0),o[0],0,0,0), C0,0); \
    GAPB(o[1]=__builtin_amdgcn_mfma_f32_32x32x16_bf16(PAF(0),VFR(4),o[1],0,0,0), C0,4); \
    KRD(GL,0); GAPB(o[0]=__builtin_amdgcn_mfma_f32_32x32x16_bf16(PAF(1),VFR(1),o[0],0,0,0), C0,8); \
    KRD(GL,1); GAPB(o[1]=__builtin_amdgcn_mfma_f32_32x32x16_bf16(PAF(1),VFR(5),o[1],0,0,0), C0,12); \
    KRD(GL,2); GAPB(o[0]=__builtin_amdgcn_mfma_f32_32x32x16_bf16(PAF(2),VFR(2),o[0],0,0,0), C1,0); \
    KRD(GL,3); GAPB(o[1]=__builtin_amdgcn_mfma_f32_32x32x16_bf16(PAF(2),VFR(6),o[1],0,0,0), C1,4); \
    GAPB(o[0]=__builtin_amdgcn_mfma_f32_32x32x16_bf16(PAF(3),VFR(3),o[0],0,0,0), C1,8); \
    GAPB(o[1]=__builtin_amdgcn_mfma_f32_32x32x16_bf16(PAF(3),VFR(7),o[1],0,0,0), C1,12); \
    }while(0)
  int t=1;
  #undef CMASK
  #define CMASK(P0,P1,t) do{}while(0)
  for(;t+7<NT;t+=2){
    STEP(pB0,pB1,pA0,pA1,t,true,true,true);     WAIT_BAR(2); RESC(); ROT();
    STEP(pA0,pA1,pB0,pB1,t+1,true,true,true);   WAIT_BAR(2); RESC(); ROT();
  }
  #undef CMASK
  #define CMASK(P0,P1,t) do{ if((t)>=NT-6) bmask(P0,P1,(t),q0+qrel,hi,lut); }while(0)
  #define ENDW(tt) do{ if((tt)+3<NT){WAIT_BAR(2);} else if((tt)+2<NT){WAIT_BAR(1);} else {WAIT_BAR(0);} }while(0)
  for(;t+1<NT;t+=2){
    STEP(pB0,pB1,pA0,pA1,t,(t+3<NT),(t+1<NT),(t+1<NT));       ENDW(t);   RESC(); ROT();
    STEP(pA0,pA1,pB0,pB1,t+1,(t+4<NT),(t+2<NT),(t+2<NT));     ENDW(t+1); RESC(); ROT();
  }
  STEP(pB0,pB1,pA0,pA1,NT-1,false,false,false); RESC();
  { float sacc=pB0[0]+pB0[1]; _Pragma("unroll") for(int r=2;r<16;++r)sacc+=pB0[r]; _Pragma("unroll") for(int r=0;r<16;++r)sacc+=pB1[r]; l_reg+=sacc;
    pw0=(u32x4){PKW(pB0,0),PKW(pB0,2),PKW(pB0,4),PKW(pB0,6)};pw1=(u32x4){PKW(pB0,8),PKW(pB0,10),PKW(pB0,12),PKW(pB0,14)};pw2=(u32x4){PKW(pB1,0),PKW(pB1,2),PKW(pB1,4),PKW(pB1,6)};pw3=(u32x4){PKW(pB1,8),PKW(pB1,10),PKW(pB1,12),PKW(pB1,14)};
    SBAR(); pv(o,vb0+sl_cur,PAF(0),PAF(1),PAF(2),PAF(3)); }
  #undef PKW
  #undef PAF
  #undef VFR
  #undef PIN
  #undef MX3
  #undef GAPA
  #undef GAPB
  #undef EX
  #undef VRD
  #undef KRD
  #undef STEP
  #undef ENDW
  {auto rr=__builtin_amdgcn_permlane32_swap(__float_as_uint(l_reg),__float_as_uint(l_reg),false,false);l_reg=__uint_as_float(rr[0])+__uint_as_float(rr[1]);}
  if(hi==0)wsf[32+r32]=l_reg;asm volatile("s_waitcnt lgkmcnt(0)":::"memory");
  float rli[16];
  #pragma unroll
  for(int r=0;r<16;++r)rli[r]=__builtin_amdgcn_rcpf(wsf[32+crow(r,hi)]);
  bf16*Ow=O+(rowbase+q0+wid*QBLK)*DM+hv*D;
  { bf16*stg=(bf16*)(shm+LDS_OST)+wid*2048;
    #pragma unroll
    for(int r=0;r<16;++r){const int orow=crow(r,hi);
      #pragma unroll
      for(int d0=0;d0<2;++d0)stg[orow*64+d0*32+r32]=__float2bfloat16(o[d0][r]*rli[r]);}
    asm volatile("s_waitcnt lgkmcnt(0)":::"memory");
    #pragma unroll
    for(int i=0;i<4;++i){const int row=i*8+(lane>>3),ch=lane&7; const u32x4 v=*(const u32x4*)(stg+row*64+ch*8); ATTN_STORE16(Ow+(long)row*DM+ch*8,v);} }
  asm volatile("s_waitcnt lgkmcnt(0)\n\ts_barrier":::"memory");
  #undef DMA_K
  #undef DMA_V
  #undef CMASK
  #undef START
  #undef RESC
  #undef ROT
}
constexpr int ATTN_LDS_BYTES=LDS_BYTES;

#undef SBAR
#undef WAIT_BAR
}
#define GAS __attribute__((address_space(1)))
#define LAS __attribute__((address_space(3)))
typedef unsigned short bf16;
typedef unsigned v4u __attribute__((ext_vector_type(4)));
typedef float f32x4 __attribute__((ext_vector_type(4)));
typedef short bf16x8 __attribute__((ext_vector_type(8)));
typedef GAS unsigned gu32;
typedef GAS unsigned long long gu64;
#define RLX_AGENT __ATOMIC_RELAXED, __HIP_MEMORY_SCOPE_AGENT
#define LDS_WAIT() asm volatile("s_waitcnt lgkmcnt(0)" ::: "memory")
#define VM_WAIT() asm volatile("s_waitcnt vmcnt(0)" ::: "memory")
__device__ __forceinline__ unsigned long long rt() { return __builtin_amdgcn_s_memrealtime(); }
__device__ __forceinline__ unsigned f2bf(float f) { unsigned u = __builtin_bit_cast(unsigned, f); return (u + 0x7fffu + ((u >> 16) & 1u)) >> 16; }
__device__ __forceinline__ unsigned pk2(float lo, float hi) { return f2bf(lo) | (f2bf(hi) << 16); }

#define XB_TMO      128
#define XB_XCNT(j)  (256  + 64 * (j))
#define XB_XSUB(j)  (1280 + 64 * (j))
#define XB_XGEN(j)  (2304 + 64 * (j))
#define XB_TOP      3328
#define XB_TOPGEN   3392
#define XCD_BAR_WORDS 3456
#define XB_SPIN_CAP (1u << 18)

__device__ __forceinline__ unsigned xb_ld(unsigned* p)              { return __hip_atomic_load(p, __ATOMIC_RELAXED, __HIP_MEMORY_SCOPE_AGENT); }
__device__ __forceinline__ unsigned xb_add(unsigned* p, unsigned v) { return __hip_atomic_fetch_add(p, v, __ATOMIC_RELAXED, __HIP_MEMORY_SCOPE_AGENT); }
__device__ __forceinline__ unsigned xb_xcc_id() { return (unsigned)__builtin_amdgcn_s_getreg((3 << 11) | 20) & 0xFu; }
#define XB_SPIN(cond, bar) do { unsigned _sp = 0; while (cond) { __builtin_amdgcn_s_sleep(1); \
    if ((++_sp & 255u) == 0u) { if (xb_ld(&(bar)[XB_TMO])) break; if (_sp > XB_SPIN_CAP) { atomicAdd(&(bar)[XB_TMO], 1u); break; } } } } while (0)

struct XcdBarrier {
    unsigned* bar; unsigned x;
    volatile LAS unsigned* st;
};

__device__ __forceinline__ XcdBarrier xcd_barrier_post(unsigned* bar, volatile LAS unsigned* st) {
    XcdBarrier b; b.bar = bar; b.x = xb_xcc_id(); b.st = st;
    if (threadIdx.x == 0) (void)xb_add(&bar[XB_XCNT(b.x)], 1u);
    return b;
}
__device__ __forceinline__ void xcd_barrier_complete(unsigned* bar, unsigned x, unsigned& nloc, unsigned& nx) {
    const unsigned G = gridDim.x * gridDim.y * gridDim.z;
    unsigned sum, cnt, mine, sp = 0u;
    for (;;) {
        sum = 0u; cnt = 0u; mine = 0u;
#pragma unroll
        for (unsigned j = 0; j < 16; ++j) { const unsigned c = xb_ld(&bar[XB_XCNT(j)]); sum += c; cnt += (c > 0u) ? 1u : 0u; mine = (j == x) ? c : mine; }
        if (sum == G) break;
        __builtin_amdgcn_s_sleep(1);
        if ((++sp & 255u) == 0u) { if (xb_ld(&bar[XB_TMO])) break; if (sp > XB_SPIN_CAP) { atomicAdd(&bar[XB_TMO], 1u); break; } }
    }
    nloc = mine > 0u ? mine : 1u; nx = cnt > 0u ? cnt : 1u;
}

__device__ __forceinline__ void xcd_barrier(const XcdBarrier& b) {
    asm volatile("s_waitcnt vmcnt(0)" ::: "memory");
    __syncthreads();
    if (threadIdx.x == 0) {
        unsigned* bar = b.bar;
        __builtin_amdgcn_s_waitcnt(0);
        unsigned nloc = b.st[0], nx = b.st[1];
        if (nloc == 0u) { xcd_barrier_complete(bar, b.x, nloc, nx); b.st[0] = nloc; b.st[1] = nx; }
        const unsigned old = xb_add(&bar[XB_XSUB(b.x)], 1u);
        const unsigned gen = old / nloc;
        if (old + 1u == (gen + 1u) * nloc) {
            __builtin_amdgcn_fence(__ATOMIC_RELEASE, "agent");
            asm volatile("s_waitcnt vmcnt(0)" ::: "memory");
            const unsigned og = xb_add(&bar[XB_TOP], 1u);
            const unsigned tg = og / nx;
            if (og + 1u == (tg + 1u) * nx) xb_add(&bar[XB_TOPGEN], 1u);
            else XB_SPIN(xb_ld(&bar[XB_TOPGEN]) == tg, bar);
            __builtin_amdgcn_fence(__ATOMIC_ACQUIRE, "agent");
            xb_add(&bar[XB_XGEN(b.x)], 1u);
            asm volatile("s_waitcnt vmcnt(0)" ::: "memory");
        } else {
            XB_SPIN(xb_ld(&bar[XB_XGEN(b.x)]) == gen, bar);
            __builtin_amdgcn_fence(__ATOMIC_ACQUIRE, "agent");
            asm volatile("s_waitcnt vmcnt(0)" ::: "memory");
        }
    }
    __syncthreads();
}

constexpr int NWAVES = 8, NTHR = 512;
constexpr int DMODEL = 2048, TP = 8192, SEQL = 4096, TSM = 32, DECB = 8, DECS = 4;
constexpr int ATTW = 1024, DIN = 4096, DFF = 5504, PLED = 256, NPAGE = 128, PAGESZ = 128, PASTLEN = 16384;
constexpr float C2F = 0.125f * 1.4426950408889634f, LOG2E = 1.4426950408889634f, NEPS = 1e-6f, SUBLN_EPS = 1e-5f, LAM_INIT = 0.2f;
enum { I_XP = 0, I_XS, I_CK, I_CV, I_SRE, I_SIM, I_SCONV, I_PT, I_PP, I_PS, I_RELB, I_NMIXG, I_WIN, I_LQ1, I_LK1, I_LQ2, I_LK2, I_SUBLNG, I_ARE, I_AIM, I_BRE, I_BIM, I_CRE, I_CIM, I_SD,
       I_LOGDT, I_GLUW, I_GLUB, I_SOUTG, I_WOUT, I_NFFNG, I_WUP, I_CONVW, I_CONVB, I_WDN, I_NPLEG, I_WPG, I_WPP, I_NFING, N_IN };
constexpr size_t O_YP = 0, O_YS = O_YP + (size_t)TP * DMODEL, O_KP = O_YS + (size_t)TSM * DMODEL, O_VP = O_KP + (size_t)TP * ATTW, O_SREP = O_VP + (size_t)TP * ATTW,
                 O_SIMP = O_SREP + 2 * 64 * 64, O_CONVP = O_SIMP + 2 * 64 * 64, O_KS = O_CONVP + 2 * 2 * DFF, O_VS = O_KS + (size_t)TSM * ATTW, O_SRES = O_VS + (size_t)TSM * ATTW,
                 O_SIMS = O_SRES + 8 * 64 * 64, O_CONVS = O_SIMS + 8 * 64 * 64, O_END = O_CONVS + 8 * 2 * DFF;
constexpr size_t al256(size_t x) { return (x + 255) & ~(size_t)255; }
constexpr size_t WS_CTL = 0, CTL_ZERO_BYTES = 1u << 20;
constexpr int CW_BAR = 4096;
constexpr size_t WS_WIN = CTL_ZERO_BYTES;
constexpr size_t WS_WOUT = WS_WIN + (size_t)DIN * DMODEL * 2;
constexpr size_t WS_WUP = WS_WOUT + (size_t)DMODEL * DMODEL * 2;
constexpr size_t WS_WDN = WS_WUP + (size_t)2 * DFF * DMODEL * 2;
constexpr size_t WS_WPG = WS_WDN + (size_t)DMODEL * DFF * 2;
constexpr size_t WS_WPP = WS_WPG + (size_t)DMODEL * DMODEL * 2;
constexpr size_t WS_XB = WS_WPP + (size_t)DMODEL * PLED * 2;
constexpr size_t WS_RSX = WS_XB + (size_t)TP * DMODEL * 2;
constexpr size_t WS_PB = WS_RSX + al256((TP + TSM) * 4);
constexpr size_t WS_QB = WS_PB + (size_t)TP * PLED * 2;
constexpr size_t WS_KB = WS_QB + (size_t)TP * ATTW * 2;
constexpr size_t WS_VB = WS_KB + (size_t)TP * ATTW * 2;
constexpr size_t WS_US = WS_VB + (size_t)TP * ATTW * 2;
constexpr size_t WS_O1 = WS_US + (size_t)TP * ATTW * 4;
constexpr size_t WS_O2 = WS_O1 + (size_t)TP * ATTW * 2;
constexpr size_t WS_GS = WS_O2 + (size_t)TP * ATTW * 2;
constexpr size_t WS_OA = WS_GS + (size_t)TP * ATTW * 2;
constexpr size_t WS_H1 = WS_OA + (size_t)TP * DMODEL * 2;
constexpr size_t WS_H1B = WS_H1 + (size_t)TP * DMODEL * 4;
constexpr size_t WS_SS1 = WS_H1B + (size_t)TP * DMODEL * 2;
constexpr size_t WS_G = WS_SS1 + (size_t)TP * 8 * 4;
constexpr size_t WS_V2 = WS_G + (size_t)TP * DFF * 2;
constexpr size_t WS_HFF = WS_V2 + (size_t)TP * DFF * 2;
constexpr size_t WS_H2 = WS_HFF + (size_t)TP * DFF * 2;
constexpr size_t WS_H2B = WS_H2 + (size_t)TP * DMODEL * 4;
constexpr size_t WS_SS2 = WS_H2B + (size_t)TP * DMODEL * 2;
constexpr size_t WS_PROJ = WS_SS2 + (size_t)TP * 8 * 4;
constexpr size_t WS_SS3 = WS_PROJ + (size_t)TP * DMODEL * 2;
constexpr size_t WS_AB = WS_SS3 + (size_t)TP * 8 * 4;
constexpr size_t WS_BBR = WS_AB + 64 * 64 * 2 * 4;
constexpr size_t WS_BBI = WS_BBR + 64 * 64 * 16 * 4;
constexpr size_t WS_LUT = WS_BBI + 64 * 64 * 16 * 4;
constexpr size_t WS_LAM = WS_LUT + al256(8 * 130 * 4);
constexpr size_t WS_XSB = WS_LAM + 256;
constexpr size_t WS_PSB = WS_XSB + (size_t)TSM * DMODEL * 2;
constexpr size_t WS_QS = WS_PSB + (size_t)TSM * PLED * 2;
constexpr size_t WS_USS = WS_QS + (size_t)TSM * ATTW * 4;
constexpr size_t WS_PROJS = WS_USS + (size_t)TSM * ATTW * 4;
constexpr size_t WS_GSS = WS_PROJS + (size_t)TSM * DMODEL * 4;
constexpr size_t WS_OAS = WS_GSS + (size_t)TSM * ATTW * 2;
constexpr size_t WS_H1S = WS_OAS + (size_t)TSM * DMODEL * 2;
constexpr size_t WS_H1SB = WS_H1S + (size_t)TSM * DMODEL * 4;
constexpr size_t WS_SS1S = WS_H1SB + (size_t)TSM * DMODEL * 2;
constexpr size_t WS_GUS = WS_SS1S + (size_t)TSM * 128 * 4;
constexpr size_t WS_VUS = WS_GUS + al256((size_t)TSM * DFF * 4);
constexpr size_t WS_HFFS = WS_VUS + al256((size_t)TSM * DFF * 4);
constexpr size_t WS_H2S = WS_HFFS + al256((size_t)TSM * DFF * 2);
constexpr size_t WS_H2SB = WS_H2S + (size_t)TSM * DMODEL * 4;
constexpr size_t WS_SS2S = WS_H2SB + (size_t)TSM * DMODEL * 2;
constexpr size_t WS_SS3S = WS_SS2S + (size_t)TSM * 128 * 4;
constexpr size_t WS_PART = WS_SS3S + (size_t)TSM * 128 * 4;
constexpr size_t WS_GF = WS_PART + al256((size_t)256 * 8 * 130 * 4);
constexpr size_t WS_VF = WS_GF + al256((size_t)64 * DFF * 4);
constexpr size_t WS_GL = WS_VF + al256((size_t)64 * DFF * 4);
constexpr size_t WS_END = WS_GL + al256((size_t)64 * DFF * 4);
constexpr int RING_OFF = 0, RING_BYTES = 131072;
constexpr int LDSCTL_OFF = RING_BYTES, MISC_OFF = LDSCTL_OFF + 320;
constexpr int LUT_OFF = RING_BYTES + 1024;
constexpr int RS_OFF = LUT_OFF + 4352;
constexpr int HAL_OFF = RS_OFF + 256;
constexpr int LUTX_OFF = 90112;
constexpr int LDS_BYTES = 147456;
static_assert(HAL_OFF + 4096 <= LDS_BYTES && HAL_OFF % 16 == 0, "LDS map");

struct Args { const float* in[N_IN]; float* out; unsigned char* ws; };

__device__ __forceinline__ float wave_sum(float v) {
#pragma unroll
    for (int o = 1; o < 64; o <<= 1) v += __shfl_xor(v, o);
    return v;
}
__device__ __forceinline__ float bflo(unsigned w) { return __uint_as_float(w << 16); }
__device__ __forceinline__ float bfhi(unsigned w) { return __uint_as_float(w & 0xffff0000u); }
__device__ __forceinline__ float sigmoidf_(float x) { return __builtin_amdgcn_rcpf(1.f + __builtin_amdgcn_exp2f(-LOG2E * x)); }
__device__ __forceinline__ float gelu_tanh(float x) { const float z = 0.7978845608028654f * (x + 0.044715f * x * x * x); return x * __builtin_amdgcn_rcpf(1.f + __builtin_amdgcn_exp2f(-2.f * LOG2E * z)); }
#define MFMA_SETTLE(x) asm volatile("s_nop 15\n\ts_nop 15" : "+v"(x))
#define WG_SYNC() do { asm volatile("s_waitcnt vmcnt(0) lgkmcnt(0)" ::: "memory"); __builtin_amdgcn_s_barrier(); asm volatile("" ::: "memory"); } while (0)

__device__ __forceinline__ void p0_transpose_item(const float* W, int K, int N, const float* gain, bf16* WT, int upmode, LAS float* scr, int item, int lane) {
    const int nblk = N / 32, kb = item / nblk, nb = item % nblk, k0 = 64 * kb, n0 = 32 * nb;
    float wv[32];
#pragma unroll
    for (int i = 0; i < 32; ++i) wv[i] = __builtin_nontemporal_load(W + (size_t)(k0 + 2 * i + (lane >> 5)) * N + n0 + (lane & 31));
#pragma unroll
    for (int i = 0; i < 32; ++i) { const int kk = 2 * i + (lane >> 5); const float g = gain ? gain[k0 + kk] : 1.f; scr[kk * 33 + (lane & 31)] = wv[i] * g; }
    LDS_WAIT(); asm volatile("" ::: "memory");
    int drow0 = n0;
    if (upmode) { const int isv = n0 >= DFF, j = isv ? n0 - DFF : n0; drow0 = 256 * (j >> 7) + (isv ? 128 : 0) + (j & 127); }
    const int c = lane & 7;
#pragma unroll
    for (int j = 0; j < 4; ++j) { const int n = (lane >> 3) + 8 * j; const LAS float* s = scr + (8 * c) * 33 + n;
        v4u o; o.x = pk2(s[0 * 33], s[1 * 33]); o.y = pk2(s[2 * 33], s[3 * 33]); o.z = pk2(s[4 * 33], s[5 * 33]); o.w = pk2(s[6 * 33], s[7 * 33]);
        *(GAS v4u*)(WT + (size_t)(drow0 + n) * K + k0 + 8 * c) = o; }
    LDS_WAIT(); asm volatile("" ::: "memory");
}
__device__ __forceinline__ void p0_row2048(const float* xrow, bf16* orow, float* rstd_out, int lane) {
    const GAS f32x4* xr = (const GAS f32x4*)xrow + lane; f32x4 v[8]; float s = 0.f;
#pragma unroll
    for (int j = 0; j < 8; ++j) { v[j] = xr[64 * j]; s += (v[j].x * v[j].x + v[j].y * v[j].y) + (v[j].z * v[j].z + v[j].w * v[j].w); }
    s = wave_sum(s);
    if (lane == 0) *rstd_out = 1.0f / sqrtf(s * (1.0f / 2048.0f) + NEPS);
    GAS unsigned long long* o8 = (GAS unsigned long long*)orow + lane;
#pragma unroll
    for (int j = 0; j < 8; ++j) o8[64 * j] = (unsigned long long)pk2(v[j].x, v[j].y) | ((unsigned long long)pk2(v[j].z, v[j].w) << 32);
}
__device__ __forceinline__ int t5_bucket(int n) {
    if (n < 16) return n;
    int b = 16 + (int)(logf((float)n / 16.0f) / 2.0794415416798357f * 16.0f);
    return b > 31 ? 31 : b;
}
__device__ __forceinline__ void p0_prologue(const Args& A, LAS unsigned char* lds, int vcu, int G, int wave, int lane) {
    unsigned char* ws = A.ws;
    LAS float* scr = (LAS float*)(lds + RING_OFF + wave * 16384);
    const int gw = vcu * NWAVES + wave, NGW = G * NWAVES;
    constexpr int I_IN = (DMODEL / 64) * (DIN / 32), I_OUT = (DMODEL / 64) * (DMODEL / 32), I_UP = (DMODEL / 64) * (2 * DFF / 32), I_DN = (DFF / 64) * (DMODEL / 32), I_PG = I_OUT, I_PPJ = (PLED / 64) * (DMODEL / 32);
    constexpr int NITEMS = I_IN + I_OUT + I_UP + I_DN + I_PG + I_PPJ;
    for (int it = gw; it < NITEMS; it += NGW) {
        int r = it;
        if (r < I_IN) { p0_transpose_item(A.in[I_WIN], DMODEL, DIN, A.in[I_NMIXG], (bf16*)(ws + WS_WIN), 0, scr, r, lane); continue; } r -= I_IN;
        if (r < I_OUT) { p0_transpose_item(A.in[I_WOUT], DMODEL, DMODEL, nullptr, (bf16*)(ws + WS_WOUT), 0, scr, r, lane); continue; } r -= I_OUT;
        if (r < I_UP) { p0_transpose_item(A.in[I_WUP], DMODEL, 2 * DFF, A.in[I_NFFNG], (bf16*)(ws + WS_WUP), 1, scr, r, lane); continue; } r -= I_UP;
        if (r < I_DN) { p0_transpose_item(A.in[I_WDN], DFF, DMODEL, nullptr, (bf16*)(ws + WS_WDN), 0, scr, r, lane); continue; } r -= I_DN;
        if (r < I_PG) { p0_transpose_item(A.in[I_WPG], DMODEL, DMODEL, A.in[I_NPLEG], (bf16*)(ws + WS_WPG), 0, scr, r, lane); continue; } r -= I_PG;
        p0_transpose_item(A.in[I_WPP], PLED, DMODEL, nullptr, (bf16*)(ws + WS_WPP), 0, scr, r, lane);
    }
    for (int m = gw; m < TP + TSM; m += NGW) {
        if (m < TP) p0_row2048(A.in[I_XP] + (size_t)m * DMODEL, (bf16*)(ws + WS_XB) + (size_t)m * DMODEL, (float*)(ws + WS_RSX) + m, lane);
        else p0_row2048(A.in[I_XS] + (size_t)(m - TP) * DMODEL, (bf16*)(ws + WS_XSB) + (size_t)(m - TP) * DMODEL, (float*)(ws + WS_RSX) + m, lane);
    }
    for (int m = gw; m < TP + TSM; m += NGW) {
        const float* src = m < TP ? A.in[I_PP] + (size_t)m * PLED : A.in[I_PS] + (size_t)(m - TP) * PLED;
        bf16* dst = m < TP ? (bf16*)(ws + WS_PB) + (size_t)m * PLED : (bf16*)(ws + WS_PSB) + (size_t)(m - TP) * PLED;
        const f32x4 v = ((const GAS f32x4*)src)[lane];
        ((GAS unsigned long long*)dst)[lane] = (unsigned long long)pk2(v.x, v.y) | ((unsigned long long)pk2(v.z, v.w) << 32);
    }
    const int gt = gw * 64 + lane;
    if (gt < 64 * 64) {
        const int g = gt >> 6;
        const float dt = expf(A.in[I_LOGDT][g]), are = A.in[I_ARE][gt], aim = A.in[I_AIM][gt];
        const float decay = expf(are * dt), abr = decay * cosf(aim * dt), abi = decay * sinf(aim * dt);
        const float den = are * are + aim * aim, numr = abr - 1.0f;
        const float cr = (numr * are + abi * aim) / den, ci = (abi * are - numr * aim) / den;
        float* AB = (float*)(ws + WS_AB); AB[gt * 2] = abr; AB[gt * 2 + 1] = abi;
        float* BBR = (float*)(ws + WS_BBR); float* BBI = (float*)(ws + WS_BBI);
        for (int c = 0; c < 16; ++c) { const float br = A.in[I_BRE][gt * 16 + c], bi = A.in[I_BIM][gt * 16 + c]; BBR[gt * 16 + c] = cr * br - ci * bi; BBI[gt * 16 + c] = cr * bi + ci * br; }
    }
    if (gt >= 4096 && gt < 4096 + 8 * 130) {
        const int q = gt - 4096, h = q / 130, idx = q % 130; const float* tb = A.in[I_RELB]; const float far = tb[31 * 8 + h];
        float v;
        if (idx == 0) v = -INFINITY; else if (idx == 129) v = 0.f; else v = (tb[t5_bucket(idx - 1) * 8 + h] - far) * LOG2E;
        ((float*)(ws + WS_LUT))[q] = v;
    }
    if (gt == 8192) {
        float s1 = 0.f, s2 = 0.f;
        for (int i = 0; i < 64; ++i) { s1 += A.in[I_LQ1][i] * A.in[I_LK1][i]; s2 += A.in[I_LQ2][i] * A.in[I_LK2][i]; }
        *(float*)(ws + WS_LAM) = expf(s1) - expf(s2) + LAM_INIT;
    }
}

template <class F> __device__ __forceinline__ void small_gemm(LAS unsigned char* lds, const bf16* A, const bf16* Bt, int N, int K, int cu, int ncu, float* ssout, F&& epi) {
    int tid_o = threadIdx.x; asm volatile("" : "+v"(tid_o));
    const int tid = tid_o, lane = tid & 63, wid = __builtin_amdgcn_readfirstlane(tid >> 6), i = lane & 15, kq = lane >> 4;
    const int nk = K / 32, ks0 = (wid * nk) / 8, ks1 = ((wid + 1) * nk) / 8, nslab = N / 16;
    LAS float* part = (LAS float*)lds;
    for (int slab = cu; slab < nslab; slab += ncu) {
        f32x4 acc0 = {0.f, 0.f, 0.f, 0.f}, acc1 = {0.f, 0.f, 0.f, 0.f};
        const bf16* bp = Bt + (size_t)(slab * 16 + i) * K + kq * 8;
        const bf16* ap0 = A + (size_t)i * K + kq * 8; const bf16* ap1 = ap0 + (size_t)16 * K;
#pragma unroll 4
        for (int ks = ks0; ks < ks1; ++ks) {
            const bf16x8 b = *(const bf16x8*)(bp + ks * 32), a0 = *(const bf16x8*)(ap0 + ks * 32), a1 = *(const bf16x8*)(ap1 + ks * 32);
            acc0 = __builtin_amdgcn_mfma_f32_16x16x32_bf16(a0, b, acc0, 0, 0, 0);
            acc1 = __builtin_amdgcn_mfma_f32_16x16x32_bf16(a1, b, acc1, 0, 0, 0);
        }
        asm volatile("s_nop 15\n\ts_nop 15" : "+v"(acc0), "+v"(acc1));
#pragma unroll
        for (int r = 0; r < 4; ++r) { part[wid * 512 + (4 * kq + r) * 16 + i] = acc0[r]; part[wid * 512 + (16 + 4 * kq + r) * 16 + i] = acc1[r]; }
        WG_SYNC();
        float v = 0.f;
#pragma unroll
        for (int w = 0; w < 8; ++w) v += part[w * 512 + tid];
        const float h = epi(tid >> 4, slab * 16 + (tid & 15), v);
        if (ssout) { float q = h * h; q += __shfl_xor(q, 1); q += __shfl_xor(q, 2); q += __shfl_xor(q, 4); q += __shfl_xor(q, 8); if ((tid & 15) == 0) ssout[(tid >> 4) * nslab + slab] = q; }
        WG_SYNC();
    }
}
__device__ __forceinline__ void sample_rstd_table(LAS unsigned char* lds, const float* ss) {
    int tid_o = threadIdx.x; asm volatile("" : "+v"(tid_o));
    const int tid = tid_o, row = tid >> 4, j = tid & 15;
    float q = 0.f;
#pragma unroll
    for (int e = 0; e < 8; ++e) q += ss[row * 128 + j * 8 + e];
    q += __shfl_xor(q, 1); q += __shfl_xor(q, 2); q += __shfl_xor(q, 4); q += __shfl_xor(q, 8);
    if (j == 0) ((LAS float*)(lds + RS_OFF))[row] = 1.0f / sqrtf(q * (1.0f / 2048.0f) + NEPS);
    WG_SYNC();
}
template <int CTRL> __device__ __forceinline__ float dppf(float x) { return __builtin_bit_cast(float, __builtin_amdgcn_update_dpp(0, __builtin_bit_cast(int, x), CTRL, 0xf, 0xf, true)); }
__device__ __forceinline__ float dot4(f32x4 a, f32x4 b) { return (a.x * b.x + a.y * b.y) + (a.z * b.z + a.w * b.w); }
struct KV4 { f32x4 k0, k1, v0, v1; };
typedef __bf16 bf16x2_t __attribute__((ext_vector_type(2)));
__device__ __forceinline__ float dot2bf(unsigned k, unsigned q, float acc) { return __builtin_amdgcn_fdot2_f32_bf16(__builtin_bit_cast(bf16x2_t, k), __builtin_bit_cast(bf16x2_t, q), acc, false); }
__device__ __forceinline__ unsigned cvtpk_u(float lo, float hi) { typedef float f32x2_t __attribute__((ext_vector_type(2))); f32x2_t v = {lo, hi}; return __builtin_bit_cast(unsigned, __builtin_convertvector(v, bf16x2_t)); }
__device__ __forceinline__ void decode_unit(const Args& A, int unit, LAS unsigned char* lds, int wid, int lane_in) {
    unsigned char* ws = A.ws;
    int lane = lane_in; asm volatile("" : "+v"(lane));
    const int bh = unit >> 2, split = unit & 3, b = bh >> 3, h = bh & 7, r = lane >> 4, c = lane & 15;
    const float* QS = (const float*)(ws + WS_QS);
    unsigned qp[4][4];
#pragma unroll
    for (int i = 0; i < 4; ++i) { const float* qp_ = QS + (size_t)(b * 4 + i) * 1024 + h * 128 + 8 * c; const f32x4 a = *(const f32x4*)qp_, bq = *(const f32x4*)(qp_ + 4);
        qp[i][0] = pk2(a.x, a.y); qp[i][1] = pk2(a.z, a.w); qp[i][2] = pk2(bq.x, bq.y); qp[i][3] = pk2(bq.z, bq.w); }
    float m[4], l[4]; f32x4 acc[4][2][2];
#pragma unroll
    for (int i = 0; i < 4; ++i) { m[i] = -INFINITY; l[i] = 0.f;
#pragma unroll
        for (int e = 0; e < 2; ++e) { acc[i][e][0] = (f32x4){0.f, 0.f, 0.f, 0.f}; acc[i][e][1] = (f32x4){0.f, 0.f, 0.f, 0.f}; } }
    const int* pt = (const int*)A.in[I_PT] + b * NPAGE + split * 32 + wid;
    const int ph0 = pt[0], ph1 = pt[8], ph2 = pt[16], ph3 = pt[24];
    const float* CK = A.in[I_CK]; const float* CV = A.in[I_CV];
    const LAS float* lut = (const LAS float*)(lds + LUT_OFF) + h * 130;
#define DEC_LOAD(buf, it_) do { const int itc_ = (it_) < 127 ? (it_) : 127; const int pg_ = itc_ >> 5; const int ph_ = pg_ == 0 ? ph0 : (pg_ == 1 ? ph1 : (pg_ == 2 ? ph2 : ph3)); \
        const size_t off_ = ((size_t)ph_ * PAGESZ + (size_t)(((itc_ & 31) << 2) + r)) * 1024 + h * 128 + 8 * c; \
        buf.k0 = __builtin_nontemporal_load((const f32x4*)(CK + off_)); buf.k1 = __builtin_nontemporal_load((const f32x4*)(CK + off_ + 4)); \
        buf.v0 = __builtin_nontemporal_load((const f32x4*)(CV + off_)); buf.v1 = __builtin_nontemporal_load((const f32x4*)(CV + off_ + 4)); } while (0)
#define DEC_COMPUTE(buf, it_) do { float s[4]; \
        const unsigned kp0_ = cvtpk_u(buf.k0.x, buf.k0.y), kp1_ = cvtpk_u(buf.k0.z, buf.k0.w), kp2_ = cvtpk_u(buf.k1.x, buf.k1.y), kp3_ = cvtpk_u(buf.k1.z, buf.k1.w); \
        _Pragma("unroll") for (int i = 0; i < 4; ++i) { float p_ = dot2bf(kp0_, qp[i][0], 0.f); p_ = dot2bf(kp1_, qp[i][1], p_); p_ = dot2bf(kp2_, qp[i][2], p_); p_ = dot2bf(kp3_, qp[i][3], p_); \
            p_ += dppf<0xB1>(p_); p_ += dppf<0x4E>(p_); p_ += dppf<0x141>(p_); s[i] = p_; } \
        const int page_ = split * 32 + wid + 8 * ((it_) >> 5); \
        if (page_ == NPAGE - 1) { const int kpos_ = page_ * PAGESZ + (((it_) & 31) << 2) + r; \
            _Pragma("unroll") for (int i = 0; i < 4; ++i) { int d_ = PASTLEN + i - kpos_ + 1; d_ = d_ > 129 ? 129 : d_; s[i] += lut[d_]; } } \
        bool need_ = false; \
        _Pragma("unroll") for (int i = 0; i < 4; ++i) need_ |= s[i] > m[i]; \
        if (__any(need_)) { \
            _Pragma("unroll") for (int i = 0; i < 4; ++i) { const float mn_ = fmaxf(m[i], s[i]); const float a_ = __builtin_amdgcn_exp2f(m[i] - mn_); m[i] = mn_; l[i] *= a_; const float ao_ = dppf<0x128>(a_); \
                acc[i][0][0] = acc[i][0][0] * a_; acc[i][0][1] = acc[i][0][1] * a_; acc[i][1][0] = acc[i][1][0] * ao_; acc[i][1][1] = acc[i][1][1] * ao_; } } \
        _Pragma("unroll") for (int i = 0; i < 4; ++i) { const float p_ = __builtin_amdgcn_exp2f(s[i] - m[i]); l[i] += p_; const float po_ = dppf<0x128>(p_); \
            acc[i][0][0] = acc[i][0][0] + buf.v0 * p_; acc[i][0][1] = acc[i][0][1] + buf.v1 * p_; acc[i][1][0] = acc[i][1][0] + buf.v0 * po_; acc[i][1][1] = acc[i][1][1] + buf.v1 * po_; } \
    } while (0)
    KV4 bA, bB, bC, bD, bE;
    DEC_LOAD(bA, 0); DEC_LOAD(bB, 1); DEC_LOAD(bC, 2); DEC_LOAD(bD, 3);
#pragma unroll 1
    for (int it = 0; it < 125; it += 5) {
        DEC_LOAD(bE, it + 4); DEC_COMPUTE(bA, it); __builtin_amdgcn_sched_barrier(0);
        DEC_LOAD(bA, it + 5); DEC_COMPUTE(bB, it + 1); __builtin_amdgcn_sched_barrier(0);
        DEC_LOAD(bB, it + 6); DEC_COMPUTE(bC, it + 2); __builtin_amdgcn_sched_barrier(0);
        DEC_LOAD(bC, it + 7); DEC_COMPUTE(bD, it + 3); __builtin_amdgcn_sched_barrier(0);
        DEC_LOAD(bD, it + 8); DEC_COMPUTE(bE, it + 4); __builtin_amdgcn_sched_barrier(0);
    }
    DEC_COMPUTE(bA, 125); __builtin_amdgcn_sched_barrier(0); DEC_COMPUTE(bB, 126); __builtin_amdgcn_sched_barrier(0); DEC_COMPUTE(bC, 127); __builtin_amdgcn_sched_barrier(0);
#undef DEC_LOAD
#undef DEC_COMPUTE
    int lane2 = lane; asm volatile("" : "+v"(lane2));
    const int r2 = lane2 >> 4, c2 = lane2 & 15;
    float m2[4][2], l2[4][2];
#pragma unroll
    for (int i = 0; i < 4; ++i) { m2[i][0] = m[i]; l2[i][0] = l[i]; m2[i][1] = __shfl_xor(m[i], 8); l2[i][1] = __shfl_xor(l[i], 8); }
#pragma unroll
    for (int sh = 16; sh <= 32; sh <<= 1)
#pragma unroll
        for (int i = 0; i < 4; ++i)
#pragma unroll
            for (int e = 0; e < 2; ++e) {
                const float mo = __shfl_xor(m2[i][e], sh), lo = __shfl_xor(l2[i][e], sh), mn = fmaxf(m2[i][e], mo);
                const float a = (m2[i][e] == -INFINITY) ? 0.f : __builtin_amdgcn_exp2f(m2[i][e] - mn), ao = (mo == -INFINITY) ? 0.f : __builtin_amdgcn_exp2f(mo - mn);
                l2[i][e] = l2[i][e] * a + lo * ao; m2[i][e] = mn;
#pragma unroll
                for (int hh = 0; hh < 2; ++hh)
#pragma unroll
                    for (int x = 0; x < 4; ++x) { const float vo = __shfl_xor(acc[i][e][hh][x], sh); acc[i][e][hh][x] = acc[i][e][hh][x] * a + vo * ao; }
            }
    LAS float* WM = (LAS float*)lds;
    if (r2 == 0) {
#pragma unroll
        for (int i = 0; i < 4; ++i)
#pragma unroll
            for (int e = 0; e < 2; ++e) { const int mp = (c2 >> 3) ^ e; LAS float* dst = WM + (size_t)(wid * 8 + i * 2 + mp) * 130;
                *(LAS f32x4*)(dst + 2 + 8 * c2) = acc[i][e][0]; *(LAS f32x4*)(dst + 2 + 8 * c2 + 4) = acc[i][e][1];
                if ((c2 & 7) == 0) { dst[0] = m2[i][e]; dst[1] = l2[i][e]; } }
    }
    WG_SYNC();
    {
        const int tid = wid * 64 + lane2, imp = tid >> 6, e2 = (tid & 63) * 2;
        float mm = -INFINITY;
#pragma unroll
        for (int w = 0; w < 8; ++w) mm = fmaxf(mm, WM[(w * 8 + imp) * 130]);
        float ll = 0.f, a0 = 0.f, a1 = 0.f;
#pragma unroll
        for (int w = 0; w < 8; ++w) { const LAS float* src = WM + (w * 8 + imp) * 130; const float mw = src[0]; const float f = (mw == -INFINITY) ? 0.f : __builtin_amdgcn_exp2f(mw - mm);
            ll += src[1] * f; a0 += src[2 + e2] * f; a1 += src[3 + e2] * f; }
        float* dst = (float*)(ws + WS_PART) + (size_t)(unit * 8 + imp) * 130;
        dst[2 + e2] = a0; dst[3 + e2] = a1; if ((tid & 63) == 0) { dst[0] = mm; dst[1] = ll; }
    }
    WG_SYNC();
}

struct SsmConst { float abr, abi, dsk, glub; bf16x8 b1[4][2]; bf16x8 c2[4]; bf16x8 w3; };
constexpr int SSM_HS = 10240, SSM_GS = 10240 + 4352;
__device__ __forceinline__ bf16x8 pack_bf8(float a0, float a1, float a2, float a3, float a4, float a5, float a6, float a7) {
    v4u w; w.x = pk2(a0, a1); w.y = pk2(a2, a3); w.z = pk2(a4, a5); w.w = pk2(a6, a7); return __builtin_bit_cast(bf16x8, w);
}
__device__ __forceinline__ void ssm_build_const(const Args& A, int g, int lane, SsmConst& C) {
    unsigned char* ws = A.ws; const int i = lane & 15, kq = lane >> 4;
    const float* AB = (const float*)(ws + WS_AB); C.abr = AB[(g * 64 + lane) * 2]; C.abi = AB[(g * 64 + lane) * 2 + 1];
    C.dsk = A.in[I_SD][g * 16 + i]; C.glub = A.in[I_GLUB][g * 16 + i];
    const bf16x8 zero = {0, 0, 0, 0, 0, 0, 0, 0};
#pragma unroll
    for (int sb = 0; sb < 4; ++sb)
#pragma unroll
        for (int part = 0; part < 2; ++part) {
            C.b1[sb][part] = zero;
            if (kq < 2) { const float* p = (const float*)(ws + (part ? WS_BBI : WS_BBR)) + (size_t)(g * 64 + 16 * sb + i) * 16 + 8 * kq; C.b1[sb][part] = pack_bf8(p[0], p[1], p[2], p[3], p[4], p[5], p[6], p[7]); }
        }
    const float* cre = A.in[I_CRE] + (size_t)(g * 16 + i) * 64; const float* cim = A.in[I_CIM] + (size_t)(g * 16 + i) * 64;
#pragma unroll
    for (int s = 0; s < 4; ++s) { const int n0 = 16 * s + 4 * kq; C.c2[s] = pack_bf8(cre[n0], -cim[n0], cre[n0 + 1], -cim[n0 + 1], cre[n0 + 2], -cim[n0 + 2], cre[n0 + 3], -cim[n0 + 3]); }
    C.w3 = zero;
    if (kq < 2) { const float* w = A.in[I_GLUW] + (size_t)(g * 16 + 8 * kq) * 16 + i; C.w3 = pack_bf8(w[0], w[16], w[32], w[48], w[64], w[80], w[96], w[112]); }
}
struct SsmIn { f32x4 x0, x1, u4; };
template <bool FULL> __device__ __forceinline__ void ssm_load(const float* us, int ntok, int lane, SsmIn& I) {
    const int i = lane & 15, kq = lane >> 4; const f32x4 fz = {0.f, 0.f, 0.f, 0.f};
    I.x0 = fz; I.x1 = fz; I.u4 = fz;
    if (kq < 2 && i < ntok) { const float* p = us + (size_t)i * 1024 + 8 * kq; I.x0 = *(const f32x4*)p; I.x1 = *(const f32x4*)(p + 4); }
    if (FULL) {
#pragma unroll
        for (int r = 0; r < 4; ++r) { const int tok = 4 * kq + r; if (tok < ntok) I.u4[r] = us[(size_t)tok * 1024 + i]; }
    }
}
template <bool FULL> __device__ __forceinline__ void ssm_tile(const SsmConst& C, const SsmIn& I, int ntok, bf16* gs, float& hr, float& hi, LAS unsigned char* wl, int lane) {
    const int i = lane & 15, kq = lane >> 4;
    const bf16x8 zero = {0, 0, 0, 0, 0, 0, 0, 0}; const f32x4 fz = {0.f, 0.f, 0.f, 0.f};
    const bf16x8 a1 = pack_bf8(I.x0.x, I.x0.y, I.x0.z, I.x0.w, I.x1.x, I.x1.y, I.x1.z, I.x1.w);
    LAS float* BUs = (LAS float*)wl;
    { f32x4 dd[4][2];
#pragma unroll
    for (int sb = 0; sb < 4; ++sb)
#pragma unroll
        for (int part = 0; part < 2; ++part) dd[sb][part] = __builtin_amdgcn_mfma_f32_16x16x32_bf16(a1, C.b1[sb][part], fz, 0, 0, 0);
    asm volatile("s_nop 15\n\ts_nop 15" : "+v"(dd[0][0]), "+v"(dd[0][1]), "+v"(dd[1][0]), "+v"(dd[1][1]), "+v"(dd[2][0]), "+v"(dd[2][1]), "+v"(dd[3][0]), "+v"(dd[3][1]));
#pragma unroll
    for (int sb = 0; sb < 4; ++sb)
#pragma unroll
        for (int part = 0; part < 2; ++part) *(LAS f32x4*)(BUs + (part * 64 + 16 * sb + i) * 20 + 4 * kq) = dd[sb][part]; }
    f32x4 br[4], bi[4];
#pragma unroll
    for (int qd = 0; qd < 4; ++qd) { br[qd] = *(const LAS f32x4*)(BUs + lane * 20 + 4 * qd); bi[qd] = *(const LAS f32x4*)(BUs + (64 + lane) * 20 + 4 * qd); }
    LAS unsigned* Hs = (LAS unsigned*)(wl + SSM_HS);
#pragma unroll
    for (int t = 0; t < 16; ++t) {
        if (t < ntok) { const float bur = br[t >> 2][t & 3], bui = bi[t >> 2][t & 3];
            const float nr = C.abr * hr - C.abi * hi + bur, ni = C.abr * hi + C.abi * hr + bui; hr = nr; hi = ni;
            if (FULL) Hs[t * 68 + lane] = pk2(hr, hi); }
    }
    if (FULL) {
        f32x4 y = fz;
#pragma unroll
        for (int s = 0; s < 4; ++s) { const bf16x8 a2 = *(const LAS bf16x8*)((LAS unsigned char*)Hs + i * 272 + (32 * s + 8 * kq) * 2); y = __builtin_amdgcn_mfma_f32_16x16x32_bf16(a2, C.c2[s], y, 0, 0, 0); }
        MFMA_SETTLE(y);
        float gg[4];
        LAS unsigned short* Gs = (LAS unsigned short*)(wl + SSM_GS);
#pragma unroll
        for (int r = 0; r < 4; ++r) { const int tok = 4 * kq + r; gg[r] = gelu_tanh(y[r] + C.dsk * I.u4[r]); Gs[tok * 24 + i] = (unsigned short)f2bf(gg[r]); }
        bf16x8 a3 = zero;
        if (kq < 2) a3 = *(const LAS bf16x8*)(Gs + i * 24 + 8 * kq);
        f32x4 gp = __builtin_amdgcn_mfma_f32_16x16x32_bf16(a3, C.w3, fz, 0, 0, 0);
        MFMA_SETTLE(gp);
#pragma unroll
        for (int r = 0; r < 4; ++r) { const int tok = 4 * kq + r; if (tok < ntok) gs[(size_t)tok * 1024 + i] = (bf16)f2bf(gg[r] * sigmoidf_(gp[r] + C.glub)); }
    }
}
template <bool FULL> __device__ __forceinline__ void ssm_run(const SsmConst& C, const float* us, bf16* gs, int ntiles, float& hr, float& hi, LAS unsigned char* wl, int lane) {
    SsmIn cur, nxt; ssm_load<FULL>(us, 16, lane, cur);
#pragma unroll 1
    for (int tile = 0; tile < ntiles; ++tile) {
        const int tn = tile + 1 < ntiles ? tile + 1 : tile;
        ssm_load<FULL>(us + (size_t)tn * 16 * 1024, 16, lane, nxt);
        ssm_tile<FULL>(C, cur, 16, FULL ? gs + (size_t)tile * 16 * 1024 : nullptr, hr, hi, wl, lane);
        cur = nxt;
    }
}
constexpr int SSM_WL2 = 15360, SSM_EX2 = 8 * SSM_WL2;
__device__ __forceinline__ void ssm_prompt_unit(const Args& A, int b, int g, int half, LAS unsigned char* lds, int wid, int lane) {
    unsigned char* ws = A.ws; LAS unsigned char* wl = lds + wid * SSM_WL2;
    SsmConst C; ssm_build_const(A, g, lane, C);
    const size_t rowA = (size_t)b * SEQL + wid * 256, rowO = rowA + (half ? 2048 : 0);
    const float* USb = (const float*)(ws + WS_US) + g * 16; bf16* GSb = (bf16*)(ws + WS_GS) + g * 16;
    LAS float* EX = (LAS float*)(lds + SSM_EX2);
    float hr = 0.f, hi = 0.f;
    if (half) { ssm_run<false>(C, USb + rowA * 1024, nullptr, 16, hr, hi, wl, lane); EX[(wid * 64 + lane) * 2] = hr; EX[(wid * 64 + lane) * 2 + 1] = hi; hr = 0.f; hi = 0.f; }
    ssm_run<false>(C, USb + rowO * 1024, nullptr, 16, hr, hi, wl, lane);
    EX[((8 + wid) * 64 + lane) * 2] = hr; EX[((8 + wid) * 64 + lane) * 2 + 1] = hi;
    WG_SYNC();
    float pr = C.abr, pi = C.abi;
#pragma unroll
    for (int k = 0; k < 8; ++k) { const float nr = pr * pr - pi * pi, ni = 2.f * pr * pi; pr = nr; pi = ni; }
    float sr = 0.f, si = 0.f;
    const int n0 = half ? 8 : 0;
    for (int w = 0; w < n0; ++w) { const float er = EX[(w * 64 + lane) * 2], ei = EX[(w * 64 + lane) * 2 + 1]; const float nr = pr * sr - pi * si + er, ni = pr * si + pi * sr + ei; sr = nr; si = ni; }
    for (int w = 0; w < wid; ++w) { const float er = EX[((8 + w) * 64 + lane) * 2], ei = EX[((8 + w) * 64 + lane) * 2 + 1]; const float nr = pr * sr - pi * si + er, ni = pr * si + pi * sr + ei; sr = nr; si = ni; }
    hr = sr; hi = si;
    ssm_run<true>(C, USb + rowO * 1024, GSb + rowO * 1024, 16, hr, hi, wl, lane);
    if (half && wid == 7) { A.out[O_SREP + (size_t)(b * 64 + g) * 64 + lane] = hr; A.out[O_SIMP + (size_t)(b * 64 + g) * 64 + lane] = hi; }
    WG_SYNC();
}
__device__ __forceinline__ void ssm_sample_wave(const Args& A, int bs, int g, LAS unsigned char* lds, int wid, int lane) {
    unsigned char* ws = A.ws; LAS unsigned char* wl = lds + wid * SSM_WL2;
    SsmConst C; ssm_build_const(A, g, lane, C);
    const size_t si_ = (size_t)(bs * 64 + g) * 64 + lane;
    float hr = A.in[I_SRE][si_], hi = A.in[I_SIM][si_];
    const float* us = (const float*)(ws + WS_USS) + (size_t)bs * 4 * 1024 + g * 16;
    SsmIn I; ssm_load<true>(us, 4, lane, I);
    ssm_tile<true>(C, I, 4, (bf16*)(ws + WS_GSS) + (size_t)bs * 4 * 1024 + g * 16, hr, hi, wl, lane);
    A.out[O_SRES + si_] = hr; A.out[O_SIMS + si_] = hi;
}

__device__ __forceinline__ void unpack16(const bf16* p, float (&v)[16]) {
    const v4u a = *(const GAS v4u*)p, b = *(const GAS v4u*)(p + 8);
    v[0] = bflo(a.x); v[1] = bfhi(a.x); v[2] = bflo(a.y); v[3] = bfhi(a.y); v[4] = bflo(a.z); v[5] = bfhi(a.z); v[6] = bflo(a.w); v[7] = bfhi(a.w);
    v[8] = bflo(b.x); v[9] = bfhi(b.x); v[10] = bflo(b.y); v[11] = bfhi(b.y); v[12] = bflo(b.z); v[13] = bfhi(b.z); v[14] = bflo(b.w); v[15] = bfhi(b.w);
}
__device__ __forceinline__ void store16(bf16* p, const float (&v)[16]) {
    v4u a, b; a.x = pk2(v[0], v[1]); a.y = pk2(v[2], v[3]); a.z = pk2(v[4], v[5]); a.w = pk2(v[6], v[7]); b.x = pk2(v[8], v[9]); b.y = pk2(v[10], v[11]); b.z = pk2(v[12], v[13]); b.w = pk2(v[14], v[15]);
    *(GAS v4u*)p = a; *(GAS v4u*)(p + 8) = b;
}
__device__ __forceinline__ void fin_ssm_row(const Args& A, const bf16* gsrow, bf16* oarow, int lane) {
    float v[16]; unpack16(gsrow + 16 * lane, v);
    float s = 0.f;
#pragma unroll
    for (int k = 0; k < 16; ++k) s += v[k] * v[k];
    s = wave_sum(s); const float rs = 1.0f / sqrtf(s * (1.0f / 1024.0f) + NEPS);
    const float* gn = A.in[I_SOUTG] + 16 * lane;
#pragma unroll
    for (int k = 0; k < 16; ++k) v[k] = v[k] * rs * gn[k];
    store16(oarow + 1024 + 16 * lane, v);
}
__device__ __forceinline__ void fin_prompt_row(const Args& A, int row, float lam, int lane) {
    unsigned char* ws = A.ws;
    float a[16], b2[16]; unpack16((const bf16*)(ws + WS_O1) + (size_t)row * 1024 + 16 * lane, a); unpack16((const bf16*)(ws + WS_O2) + (size_t)row * 1024 + 16 * lane, b2);
    float s = 0.f;
#pragma unroll
    for (int k = 0; k < 16; ++k) { a[k] = a[k] - lam * b2[k]; s += a[k] * a[k]; }
    s += __shfl_xor(s, 1); s += __shfl_xor(s, 2); s += __shfl_xor(s, 4);
    const float rs = (1.0f - LAM_INIT) / sqrtf(s * (1.0f / 128.0f) + SUBLN_EPS);
    const float* gn = A.in[I_SUBLNG] + 16 * lane;
#pragma unroll
    for (int k = 0; k < 16; ++k) a[k] = a[k] * rs * gn[k];
    bf16* oarow = (bf16*)(ws + WS_OA) + (size_t)row * 2048;
    store16(oarow + 16 * lane, a);
    fin_ssm_row(A, (const bf16*)(ws + WS_GS) + (size_t)row * 1024, oarow, lane);
}
__device__ __forceinline__ void fin_sample_attn(const Args& A, int task, float lam, LAS unsigned char* lds, int lane) {
    unsigned char* ws = A.ws; const int i = task & 3, h = (task >> 2) & 7, b = task >> 5, row = b * 4 + i;
    const LAS float* lut = (const LAS float*)(lds + LUT_OFF) + h * 130;
    const float* QS = (const float*)(ws + WS_QS); const float* KS = A.out + O_KS; const float* VS = A.out + O_VS;
    float o[2][2];
#pragma unroll
    for (int mp = 0; mp < 2; ++mp) {
        const float qv = QS[(size_t)row * 1024 + h * 128 + mp * 64 + lane];
        float sn[4];
#pragma unroll
        for (int j = 0; j < 4; ++j) { const float kv = KS[(size_t)(b * 4 + j) * 1024 + h * 128 + mp * 64 + lane]; sn[j] = wave_sum(qv * kv) + lut[(i - j) + 1 < 0 ? 0 : (i - j) + 1]; }
        const float* P = (const float*)(ws + WS_PART) + (size_t)((b * 8 + h) * 4) * 8 * 130 + (size_t)(i * 2 + mp) * 130;
        float mm = -INFINITY;
#pragma unroll
        for (int s = 0; s < 4; ++s) mm = fmaxf(mm, P[(size_t)s * 8 * 130]);
#pragma unroll
        for (int j = 0; j < 4; ++j) if (j <= i) mm = fmaxf(mm, sn[j]);
        float ll = 0.f, a0 = 0.f, a1 = 0.f;
#pragma unroll
        for (int s = 0; s < 4; ++s) { const float* ps = P + (size_t)s * 8 * 130; const float f = __builtin_amdgcn_exp2f(ps[0] - mm); ll += ps[1] * f; a0 += ps[2 + 2 * lane] * f; a1 += ps[3 + 2 * lane] * f; }
#pragma unroll
        for (int j = 0; j < 4; ++j) if (j <= i) { const float p = __builtin_amdgcn_exp2f(sn[j] - mm); const float* vr = VS + (size_t)(b * 4 + j) * 1024 + h * 128 + 2 * lane; ll += p; a0 += p * vr[0]; a1 += p * vr[1]; }
        const float inv = 1.0f / ll; o[mp][0] = a0 * inv; o[mp][1] = a1 * inv;
    }
    const float d0 = o[0][0] - lam * o[1][0], d1 = o[0][1] - lam * o[1][1];
    const float s = wave_sum(d0 * d0 + d1 * d1), rs = (1.0f - LAM_INIT) / sqrtf(s * (1.0f / 128.0f) + SUBLN_EPS);
    const float* gn = A.in[I_SUBLNG] + h * 128 + 2 * lane;
    *(GAS unsigned*)((bf16*)(ws + WS_OAS) + (size_t)row * 2048 + h * 128 + 2 * lane) = pk2(d0 * rs * gn[0], d1 * rs * gn[1]);
}

__device__ __forceinline__ void unpack8(v4u a, float (&v)[8]) { v[0] = bflo(a.x); v[1] = bfhi(a.x); v[2] = bflo(a.y); v[3] = bfhi(a.y); v[4] = bflo(a.z); v[5] = bfhi(a.z); v[6] = bflo(a.w); v[7] = bfhi(a.w); }
__device__ __forceinline__ float siluf_(float x) { return x * sigmoidf_(x); }
__device__ __forceinline__ void p4b_conv(const Args& A, int gtid, int nthreads) {
    unsigned char* ws = A.ws;
    { const float* GF = (const float*)(ws + WS_GF); const float* VF = (const float*)(ws + WS_VF); const float* GL = (const float*)(ws + WS_GL); bf16* HFF = (bf16*)(ws + WS_HFF);
      for (int it = gtid; it < 64 * DFF; it += nthreads) {
        const int pr = it / DFF, j = it % DFF, p = pr >> 1, r = pr & 1; const bool first = (p & 15) == 0;
        const float gm2 = first ? 0.f : GL[(size_t)((p - 1) * 2) * DFF + j], gm1 = first ? 0.f : GL[(size_t)((p - 1) * 2 + 1) * DFF + j];
        const float g0 = GF[(size_t)(p * 2) * DFF + j], g1 = GF[(size_t)(p * 2 + 1) * DFF + j];
        const float x0 = r == 0 ? gm2 : gm1, x1 = r == 0 ? gm1 : g0, x2 = r == 0 ? g0 : g1;
        const float cv = A.in[I_CONVB][j] + A.in[I_CONVW][j] * x0 + A.in[I_CONVW][DFF + j] * x1 + A.in[I_CONVW][2 * DFF + j] * x2;
        HFF[(size_t)(p * 256 + r) * DFF + j] = (bf16)f2bf(siluf_(cv) * VF[(size_t)pr * DFF + j]);
      } }
    const float* GU = (const float*)(ws + WS_GUS); const float* VU = (const float*)(ws + WS_VUS); bf16* HS = (bf16*)(ws + WS_HFFS);
    for (int it = gtid; it < TSM * DFF; it += nthreads) {
        const int row = it / DFF, j = it % DFF, bs = row >> 2, t = row & 3;
        const float* sc = A.in[I_SCONV] + (size_t)bs * 2 * DFF + j;
        const float x2 = GU[(size_t)row * DFF + j];
        const float x1 = t >= 1 ? GU[(size_t)(row - 1) * DFF + j] : sc[DFF];
        const float x0 = t >= 2 ? GU[(size_t)(row - 2) * DFF + j] : (t == 1 ? sc[DFF] : sc[0]);
        const float cv = A.in[I_CONVB][j] + A.in[I_CONVW][j] * x0 + A.in[I_CONVW][DFF + j] * x1 + A.in[I_CONVW][2 * DFF + j] * x2;
        HS[(size_t)row * DFF + j] = (bf16)f2bf(siluf_(cv) * VU[(size_t)row * DFF + j]);
    }
}
#ifndef PH_MASK
#define PH_MASK 0xFFFF
#endif
#define PHEN(k) (((PH_MASK) >> (k)) & 1)
#ifndef PH_REP
#define PH_REP -1
#endif
#define PHREP(k) for (int rep_ = 0; rep_ < ((PH_REP == (k)) ? 2 : 1); ++rep_)
#ifndef DEC_SLOT
#define DEC_SLOT(v) ((v) & 3)
#endif
__global__ void __launch_bounds__(NWAVES * 64, 2) hymba_fwd(Args args) {
    extern __shared__ __attribute__((aligned(16))) unsigned char lds_raw[];
    LAS unsigned char* lds = (LAS unsigned char*)lds_raw;
    const int G = gridDim.x;
    unsigned char* ws = args.ws;
#define PH_LOCALS() int tid = threadIdx.x; asm volatile("" : "+v"(tid)); int bx = blockIdx.x; asm volatile("" : "+s"(bx)); \
    const int lane = tid & 63, wave = __builtin_amdgcn_readfirstlane(tid >> 6), vcu = (G % 8 == 0) ? (bx % 8) * (G / 8) + bx / 8 : bx; \
    const int gw = vcu * NWAVES + wave, NGW = G * NWAVES, gtid = gw * 64 + lane, NT_ALL = NGW * 64; (void)lane; (void)wave; (void)vcu; (void)gw; (void)NGW; (void)gtid; (void)NT_ALL; (void)bx
    XcdBarrier bar;
    {
        PH_LOCALS();
        gu32* ctl = (gu32*)(ws + WS_CTL);
        for (int u = tid; u < (LDS_BYTES - LDSCTL_OFF) / 4; u += NWAVES * 64) ((LAS unsigned*)(lds + LDSCTL_OFF))[u] = 0u;
        __syncthreads();
        volatile LAS unsigned* MISC = (volatile LAS unsigned*)(lds + MISC_OFF);
        bar = xcd_barrier_post((unsigned*)(ctl + CW_BAR), MISC + 8);
    }

    if (PHEN(0)) PHREP(0) { PH_LOCALS();
    p0_prologue(args, lds, vcu, G, wave, lane);
    }
    xcd_barrier(bar);

    {
        PH_LOCALS();
        for (int u = tid; u < 8 * 130; u += NTHR) ((LAS float*)(lds + LUT_OFF))[u] = ((const float*)(ws + WS_LUT))[u];
        __syncthreads();
    }

    if (PHEN(1)) PHREP(1) { PH_LOCALS();
    {
        pg8::Gemm g{(const pg8::bf16_t*)(ws + WS_XB), (const pg8::bf16_t*)(ws + WS_WIN), TP, DIN, DMODEL}; pg8::StaticOrder S; S.init(TP, DIN, G, bx);
        pg8::EpiIn E{(const float*)(ws + WS_RSX), (pg8::bf16_t*)(ws + WS_QB), (pg8::bf16_t*)(ws + WS_KB), (pg8::bf16_t*)(ws + WS_VB), (float*)(ws + WS_US), args.out + O_KP, args.out + O_VP, C2F};
        pg8::gemm_phase<pg8::EpiIn, pg8::StaticOrder, true, true>(lds + RING_OFF, g, S, E);
    }
    {
        pg8::Gemm g{(const pg8::bf16_t*)(ws + WS_PB), (const pg8::bf16_t*)(ws + WS_WPP), TP, DMODEL, PLED}; pg8::StaticOrder S; S.init(TP, DMODEL, G, bx);
        pg8::EpiPlain E{(pg8::bf16_t*)(ws + WS_PROJ), DMODEL};
        pg8::gemm_phase<pg8::EpiPlain, pg8::StaticOrder, true, true>(lds + RING_OFF, g, S, E);
    }
    {
        const float* rsx = (const float*)(ws + WS_RSX) + TP; float* QS = (float*)(ws + WS_QS); float* USS = (float*)(ws + WS_USS); float* out = args.out;
        small_gemm(lds, (const bf16*)(ws + WS_XSB), (const bf16*)(ws + WS_WIN), DIN, DMODEL, vcu, G, nullptr, [=](int row, int col, float v) -> float {
            v *= rsx[row]; const int sec = col >> 10, c = col & 1023;
            if (sec == 0) QS[row * 1024 + c] = v * C2F; else if (sec == 1) out[O_KS + row * 1024 + c] = v; else if (sec == 2) out[O_VS + row * 1024 + c] = v; else USS[row * 1024 + c] = v;
            return v; });
        float* PJ = (float*)(ws + WS_PROJS);
        small_gemm(lds, (const bf16*)(ws + WS_PSB), (const bf16*)(ws + WS_WPP), DMODEL, PLED, vcu, G, nullptr, [=](int row, int col, float v) -> float { PJ[row * 2048 + col] = v; return v; });
    }
    }
    xcd_barrier(bar);

    if (PHEN(2)) { PH_LOCALS();
    if (PHEN(10)) PHREP(10) { if (vcu < 256) decode_unit(args, vcu, lds, wave, lane); }
    if (PHEN(11)) PHREP(11) {
        const attn_body::bf16* Qp = (const attn_body::bf16*)(ws + WS_QB); const attn_body::bf16* Kp = (const attn_body::bf16*)(ws + WS_KB); const attn_body::bf16* Vp = (const attn_body::bf16*)(ws + WS_VB);
        { const int L0 = vcu * 4;
            const int pair = L0 >> 4, s4 = (L0 >> 2) & 3, b = pair >> 5, vh = pair & 31, hh = vh >> 2, mp = (vh >> 1) & 1, vhalf = vh & 1;
            attn_body::bf16* Op = (attn_body::bf16*)(ws + (mp ? WS_O2 : WS_O1));
            for (int u = tid; u < 640; u += NTHR) { const int d = u - 256; ((LAS float*)(lds + LUTX_OFF))[u] = d < 0 ? -INFINITY : (d < 128 ? ((const LAS float*)(lds + LUT_OFF))[hh * 130 + 1 + d] : 0.f); }
            __syncthreads();
            attn_body::lds_cfptr lut = (attn_body::lds_cfptr)(lds + LUTX_OFF);
#pragma unroll 1
            for (int i = 0; i < 4; ++i) { const int qb = (i == 0) ? s4 : (i == 1) ? 7 - s4 : (i == 2) ? 8 + s4 : 15 - s4;
                attn_body::attn_unit<8>(b, 2 * hh + mp, 2 * hh + vhalf, qb, Qp, Kp, Vp, Op, (char*)lds_raw + RING_OFF, lut); }
        }
    }
    __syncthreads();
    if (PHEN(12)) PHREP(12) { if (vcu < 256) ssm_prompt_unit(args, vcu >> 7, (vcu >> 1) & 63, vcu & 1, lds, wave, lane); }
    if (PHEN(13)) { const int u = gw; if (u < 512) ssm_sample_wave(args, u >> 6, u & 63, lds, wave, lane); }
    }
    xcd_barrier(bar);

    if (PHEN(3)) PHREP(3) { PH_LOCALS(); const float lam = *(const float*)(ws + WS_LAM);
    for (int row = gw; row < TP; row += NGW) fin_prompt_row(args, row, lam, lane);
    for (int row = gw; row < TSM; row += NGW) fin_ssm_row(args, (const bf16*)(ws + WS_GSS) + (size_t)row * 1024, (bf16*)(ws + WS_OAS) + (size_t)row * 2048, lane);
    for (int t = NGW - 1 - gw; t < 256; t += NGW) fin_sample_attn(args, t, lam, lds, lane);
    }
    xcd_barrier(bar);

    if (PHEN(4)) PHREP(4) { PH_LOCALS();
    {
        pg8::Gemm g{(const pg8::bf16_t*)(ws + WS_OA), (const pg8::bf16_t*)(ws + WS_WOUT), TP, DMODEL, DMODEL}; pg8::StaticOrder S; S.init(TP, DMODEL, G, bx);
        pg8::EpiRes<0> E{args.in[I_XP], (float*)(ws + WS_H1), (pg8::bf16_t*)(ws + WS_H1B), (float*)(ws + WS_SS1), nullptr, nullptr};
        if (G == 256) pg8::gemm_phase<pg8::EpiRes<0>, pg8::StaticOrder, false, true>(lds + RING_OFF, g, S, E);
        const float* xs = args.in[I_XS]; float* H1S = (float*)(ws + WS_H1S); bf16* H1SB = (bf16*)(ws + WS_H1SB);
        small_gemm(lds, (const bf16*)(ws + WS_OAS), (const bf16*)(ws + WS_WOUT), DMODEL, DMODEL, vcu, G, (float*)(ws + WS_SS1S), [=](int row, int col, float v) -> float {
            const float h = xs[row * 2048 + col] + v; H1S[row * 2048 + col] = h; H1SB[row * 2048 + col] = (bf16)f2bf(h); return h; });
    }
    }
    xcd_barrier(bar);

    if (PHEN(5)) PHREP(5) { PH_LOCALS();
    {
        pg8::Gemm g{(const pg8::bf16_t*)(ws + WS_H1B), (const pg8::bf16_t*)(ws + WS_WUP), TP, 2 * DFF, DMODEL}; pg8::StaticOrder S; S.init(TP, 2 * DFF, G, bx);
        pg8::EpiUpConv E{(const float*)(ws + WS_SS1), (pg8::bf16_t*)(ws + WS_HFF), args.out + O_CONVP, args.in[I_CONVW], args.in[I_CONVB], (float*)(ws + WS_GF), (float*)(ws + WS_VF), (float*)(ws + WS_GL), (LAS float*)(lds + HAL_OFF), DFF};
        pg8::gemm_phase<pg8::EpiUpConv, pg8::StaticOrder, true, true>(lds + RING_OFF, g, S, E);
        sample_rstd_table(lds, (const float*)(ws + WS_SS1S));
        const LAS float* RS = (const LAS float*)(lds + RS_OFF); float* GU = (float*)(ws + WS_GUS); float* VU = (float*)(ws + WS_VUS); float* out = args.out;
        small_gemm(lds, (const bf16*)(ws + WS_H1SB), (const bf16*)(ws + WS_WUP), 2 * DFF, DMODEL, vcu, G, nullptr, [=](int row, int col, float v) -> float {
            v *= RS[row]; const int j = (col >> 8) * 128 + (col & 127);
            if (col & 128) VU[row * DFF + j] = v; else { GU[row * DFF + j] = v; if ((row & 3) >= 2) out[O_CONVS + (size_t)((row >> 2) * 2 + (row & 3) - 2) * DFF + j] = v; }
            return v; });
    }
    }
    xcd_barrier(bar);

    if (PHEN(6)) PHREP(6) { PH_LOCALS();
    p4b_conv(args, gtid, NT_ALL);
    }
    xcd_barrier(bar);

    if (PHEN(7)) PHREP(7) { PH_LOCALS();
    {
        pg8::Gemm g{(const pg8::bf16_t*)(ws + WS_HFF), (const pg8::bf16_t*)(ws + WS_WDN), TP, DMODEL, DFF}; pg8::StaticOrder S; S.init(TP, DMODEL, G, bx);
        pg8::EpiRes<0> E{(const float*)(ws + WS_H1), (float*)(ws + WS_H2), (pg8::bf16_t*)(ws + WS_H2B), (float*)(ws + WS_SS2), nullptr, nullptr};
        if (G == 256) pg8::gemm_phase<pg8::EpiRes<0>, pg8::StaticOrder, false, true>(lds + RING_OFF, g, S, E);
        const float* H1S = (const float*)(ws + WS_H1S); float* H2S = (float*)(ws + WS_H2S); bf16* H2SB = (bf16*)(ws + WS_H2SB);
        small_gemm(lds, (const bf16*)(ws + WS_HFFS), (const bf16*)(ws + WS_WDN), DMODEL, DFF, vcu, G, (float*)(ws + WS_SS2S), [=](int row, int col, float v) -> float {
            const float h = H1S[row * 2048 + col] + v; H2S[row * 2048 + col] = h; H2SB[row * 2048 + col] = (bf16)f2bf(h); return h; });
    }
    }
    xcd_barrier(bar);

    if (PHEN(8)) PHREP(8) { PH_LOCALS();
    {
        pg8::Gemm g{(const pg8::bf16_t*)(ws + WS_H2B), (const pg8::bf16_t*)(ws + WS_WPG), TP, DMODEL, DMODEL}; pg8::StaticOrder S; S.init(TP, DMODEL, G, bx);
        pg8::EpiRes<1> E{(const float*)(ws + WS_H2), args.out + O_YP, nullptr, (float*)(ws + WS_SS3), (const float*)(ws + WS_SS2), (const pg8::bf16_t*)(ws + WS_PROJ)};
        if (G == 256) pg8::gemm_phase<pg8::EpiRes<1>, pg8::StaticOrder, false, true>(lds + RING_OFF, g, S, E);
        sample_rstd_table(lds, (const float*)(ws + WS_SS2S));
        const LAS float* RS = (const LAS float*)(lds + RS_OFF); const float* H2S = (const float*)(ws + WS_H2S); const float* PJ = (const float*)(ws + WS_PROJS); float* out = args.out;
        small_gemm(lds, (const bf16*)(ws + WS_H2SB), (const bf16*)(ws + WS_WPG), DMODEL, DMODEL, vcu, G, (float*)(ws + WS_SS3S), [=](int row, int col, float v) -> float {
            const float h = H2S[row * 2048 + col] + sigmoidf_(v * RS[row]) * PJ[row * 2048 + col]; out[O_YS + row * 2048 + col] = h; return h; });
    }
    }
    xcd_barrier(bar);

    if (PHEN(9)) { PH_LOCALS();
    for (int row = gw; row < TP + TSM; row += NGW) {
        float* yrow; float rs;
        if (row < TP) { yrow = args.out + O_YP + (size_t)row * DMODEL; rs = pg8::rstd8((const float*)(ws + WS_SS3) + (size_t)row * 8); }
        else { const int r = row - TP; yrow = args.out + O_YS + (size_t)r * DMODEL; const float* ss = (const float*)(ws + WS_SS3S) + r * 128; const float q = wave_sum(ss[lane] + ss[64 + lane]); rs = 1.0f / sqrtf(q * (1.0f / 2048.0f) + NEPS); }
        GAS f32x4* yr = (GAS f32x4*)yrow + lane; const GAS f32x4* gn = (const GAS f32x4*)args.in[I_NFING] + lane;
#pragma unroll
        for (int j = 0; j < 8; ++j) { f32x4 v = yr[64 * j]; const f32x4 g4 = gn[64 * j]; v = v * rs * g4; yr[64 * j] = v; }
    }
    }
}

extern "C" void kernel_launch(void* const* d_in, const int* in_sizes, int n_in, void* d_out, int out_size, void* d_ws, size_t ws_size, hipStream_t stream) {
    static int grid = 0;
    if (grid == 0) {
        if (n_in != N_IN || (size_t)out_size != O_END || ws_size < WS_END) { fprintf(stderr, "kernel_launch: unexpected shapes: n_in %d out %d ws %zu (need %d, %zu, %zu)\n", n_in, out_size, ws_size, (int)N_IN, (size_t)O_END, (size_t)WS_END); grid = -1; return; }
        int dev = 0, cus = 0, per_cu = 0;
        if (hipGetDevice(&dev) != hipSuccess || hipDeviceGetAttribute(&cus, hipDeviceAttributeMultiprocessorCount, dev) != hipSuccess) { grid = -1; return; }
        if (hipFuncSetAttribute((const void*)hymba_fwd, hipFuncAttributeMaxDynamicSharedMemorySize, LDS_BYTES) != hipSuccess) { fprintf(stderr, "kernel_launch: hipFuncSetAttribute failed\n"); grid = -1; return; }
        if (hipOccupancyMaxActiveBlocksPerMultiprocessor(&per_cu, (const void*)hymba_fwd, NWAVES * 64, LDS_BYTES) != hipSuccess || per_cu < 1) fprintf(stderr, "kernel_launch: occupancy query reports %d\n", per_cu);
        (void)hipGetLastError();
        grid = cus;
        if (grid != 256) fprintf(stderr, "kernel_launch: %d CUs (built for 256)\n", grid);
    }
    if (grid < 0) return;
    if (hipMemsetAsync((char*)d_ws + WS_CTL, 0, CTL_ZERO_BYTES, stream) != hipSuccess) return;
    Args a{};
    for (int i = 0; i < N_IN; ++i) a.in[i] = (const float*)d_in[i];
    a.out = (float*)d_out; a.ws = (unsigned char*)d_ws;
    hipLaunchKernelGGL(hymba_fwd, dim3(grid), dim3(NWAVES * 64), LDS_BYTES, stream, a);
}
```
